# Optimizing an MI355X kernel written in HIP

```python
import math
import jax, jax.numpy as jnp
from jax import lax
import numpy as np

D_MODEL = 4096
BATCH = 1
SEQ = 8192
DEPTH = 1

HEAD_DIM = 128
MIX_WIDTH = D_MODEL
MIX_HEADS = MIX_WIDTH // HEAD_DIM
A_Q_HEADS = MIX_HEADS // 2
A_KV_HEADS = 4
A_WIDTH = A_Q_HEADS * HEAD_DIM
A_WINDOW = 128
B_Q_HEADS = MIX_HEADS - A_Q_HEADS
B_KV_HEADS = 4
B_WIDTH = B_Q_HEADS * HEAD_DIM
CMP_BLOCK = 32
CMP_STRIDE = 16
CMP_HIDDEN = 256
SLC_BLOCK = 64
SLC_TOPK = 16
B_WINDOW = 512
N_BRANCH = 3
QBLOCK = 128
N_BUCKETS = 32
MAX_DISTANCE = 128
D_FF = 11008
CONV_WIDTH = 3
EPS = 1e-6
NEG = -1e30
FORCE_SCORE = 1e6
SCALE = HEAD_DIM ** -0.5
IN_SIZES = [A_WIDTH, A_KV_HEADS * HEAD_DIM, A_KV_HEADS * HEAD_DIM,
            B_WIDTH] + [B_KV_HEADS * HEAD_DIM] * 6 + [N_BRANCH * B_Q_HEADS]
N_IN = A_WIDTH + 2 * A_KV_HEADS * HEAD_DIM + B_WIDTH + 6 * B_KV_HEADS * HEAD_DIM + N_BRANCH * B_Q_HEADS

kernel_name = "hymba_style_swa_sinks_nsa_convffn"


def rms_norm(x, g):
    xf = x.astype(jnp.float32)
    y = xf * lax.rsqrt(jnp.mean(xf * xf, axis=-1, keepdims=True) + EPS)
    return (y * g.astype(jnp.float32)).astype(x.dtype)


def t5_bucket(dist):
    n = jnp.maximum(dist, 0)
    max_exact = N_BUCKETS // 2
    nf = jnp.maximum(n, 1).astype(jnp.float32)
    large = max_exact + (jnp.log(nf / max_exact) / math.log(MAX_DISTANCE / max_exact)
                         * (N_BUCKETS - max_exact)).astype(jnp.int32)
    large = jnp.minimum(large, N_BUCKETS - 1)
    return jnp.where(n < max_exact, n, large)


def banded_attention(q, k, v, tab, window, sinks):
    B, S, H, D = q.shape
    G = k.shape[2]
    R = H // G
    nb = S // QBLOCK
    nback = -(-(window - 1) // QBLOCK)
    K = (nback + 1) * QBLOCK
    qb = q.reshape(B, nb, QBLOCK, G, R, D)

    def band(t):
        tb = t.reshape(B, nb, QBLOCK, G, D)
        parts = [jnp.pad(tb, ((0, 0), (j, 0), (0, 0), (0, 0), (0, 0)))[:, :nb]
                 for j in range(nback, -1, -1)]
        return jnp.concatenate(parts, axis=2)

    kb, vb = band(k), band(v)
    rel = (jnp.arange(QBLOCK)[:, None] + nback * QBLOCK) - jnp.arange(K)[None, :]
    kglob = jnp.arange(nb)[:, None] * QBLOCK - nback * QBLOCK + jnp.arange(K)[None, :]
    mask = ((rel >= 0) & (rel < window))[None] & (kglob >= 0)[:, None, :]
    bias = jnp.moveaxis(tab[t5_bucket(rel)], -1, 0).reshape(G, R, QBLOCK, K).astype(jnp.float32)
    logits = jnp.einsum('bcqgrd,bckgd->bcgrqk', qb, kb).astype(jnp.float32) * SCALE + bias
    logits = jnp.where(mask[:, None, None], logits, NEG)
    if sinks is not None:
        s = sinks.astype(jnp.float32).reshape(G, R)[:, :, None, None]
        m = jnp.maximum(jnp.max(logits, axis=-1, keepdims=True), s)
        e = jnp.exp(logits - m)
        p = e / (jnp.sum(e, axis=-1, keepdims=True) + jnp.exp(s - m))
    else:
        p = jax.nn.softmax(logits, axis=-1)
    out = jnp.einsum('bcgrqk,bckgd->bcqgrd', p.astype(v.dtype), vb)
    return out.reshape(B, S, H, D)


def compress(t, pos_emb, w1, b1, w2, b2):
    B, S, G, D = t.shape
    n = (S - CMP_BLOCK) // CMP_STRIDE + 1
    idx = np.arange(n)[:, None] * CMP_STRIDE + np.arange(CMP_BLOCK)[None, :]
    blocks = t[:, idx] + pos_emb[:, None, :]
    blocks = jnp.moveaxis(blocks, 3, 2).reshape(B, n, G, CMP_BLOCK * D)
    return jax.nn.gelu(blocks @ w1 + b1) @ w2 + b2


def compressed_attention(q, kc, vc, tab):
    B, S, H, D = q.shape
    N, G = kc.shape[1], kc.shape[2]
    R = H // G
    qg = q.reshape(B, S, G, R, D)
    end = jnp.arange(N) * CMP_STRIDE + CMP_BLOCK - 1
    dist = jnp.arange(S)[:, None] - end[None, :]
    valid = dist >= 0
    bias = jnp.moveaxis(tab[t5_bucket(dist)], -1, 0).reshape(G, R, S, N).astype(jnp.float32)
    logits = jnp.einsum('bsgrd,bngd->bgrsn', qg, kc).astype(jnp.float32) * SCALE + bias
    logits = jnp.where(valid, logits, NEG)
    has_any = jnp.any(valid, axis=-1)[:, None].astype(jnp.float32)
    p = jax.nn.softmax(logits, axis=-1) * has_any
    out = jnp.einsum('bgrsn,bngd->bsgrd', p.astype(vc.dtype), vc).reshape(B, S, H, D)
    return out, jnp.sum(p, axis=2)


def select_blocks(p_grp, S):
    n_slc = S // SLC_BLOCK
    N = p_grp.shape[-1]
    i = np.arange(N)[:, None]
    j = np.arange(n_slc)[None, :]
    overlap = ((i * CMP_STRIDE <= j * SLC_BLOCK + SLC_BLOCK - 1)
               & (i * CMP_STRIDE + CMP_BLOCK - 1 >= j * SLC_BLOCK)).astype(np.float32)
    scores = jnp.einsum('bgsn,nj->bgsj', p_grp, jnp.asarray(overlap, p_grp.dtype))
    cur = jnp.arange(S)[:, None] // SLC_BLOCK
    blk = jnp.arange(n_slc)[None, :]
    forced = (blk == 0) | (blk == cur) | (blk == cur - 1)
    scores = jnp.where(forced, FORCE_SCORE, jnp.where(blk <= cur, scores, -1.0))
    _, idx = lax.top_k(scores, min(SLC_TOPK, n_slc))
    return idx


def selected_attention(q, ks, vs, idx, tab):
    B, S, H, D = q.shape
    G = ks.shape[2]
    R = H // G
    k_sel = idx.shape[-1]
    n_slc = S // SLC_BLOCK
    nc = S // QBLOCK
    kblk = ks.reshape(B, n_slc, SLC_BLOCK, G, D).transpose(0, 3, 1, 2, 4)
    vblk = vs.reshape(B, n_slc, SLC_BLOCK, G, D).transpose(0, 3, 1, 2, 4)
    tab_gr = tab.T.reshape(G, R, N_BUCKETS)
    q_c = jnp.moveaxis(q.reshape(B, nc, QBLOCK, G, R, D), 1, 0)
    idx_c = jnp.moveaxis(idx.reshape(B, G, nc, QBLOCK, k_sel), 2, 0)
    starts = jnp.arange(nc) * QBLOCK
    bi = jnp.arange(B)[:, None, None, None]
    gi = jnp.arange(G)[None, :, None, None]
    offs = jnp.arange(SLC_BLOCK)
    g5 = jnp.arange(G)[None, :, None, None, None]
    r5 = jnp.arange(R)[None, None, :, None, None]

    def one_block(args):
        qc, ic, s0 = args
        kg = kblk[bi, gi, ic].reshape(B, G, QBLOCK, k_sel * SLC_BLOCK, D)
        vg = vblk[bi, gi, ic].reshape(B, G, QBLOCK, k_sel * SLC_BLOCK, D)
        tok = (ic[..., None] * SLC_BLOCK + offs).reshape(B, G, QBLOCK, k_sel * SLC_BLOCK)
        dist = (s0 + jnp.arange(QBLOCK))[None, None, :, None] - tok
        bias = tab_gr[g5, r5, t5_bucket(dist)[:, :, None]].astype(jnp.float32)
        logits = jnp.einsum('bqgrd,bgqkd->bgrqk', qc, kg).astype(jnp.float32) * SCALE + bias
        logits = jnp.where((dist >= 0)[:, :, None], logits, NEG)
        p = jax.nn.softmax(logits, axis=-1)
        return jnp.einsum('bgrqk,bgqkd->bqgrd', p.astype(vg.dtype), vg)

    out = lax.map(one_block, (q_c, idx_c, starts))
    return jnp.moveaxis(out, 0, 1).reshape(B, S, H, D)


def causal_dwconv(u, w, b):
    S = u.shape[1]
    up = jnp.pad(u, ((0, 0), (CONV_WIDTH - 1, 0), (0, 0)))
    y = b
    for j in range(CONV_WIDTH):
        y = y + up[:, j:j + S] * w[j]
    return y


def hybrid_layer(x, rel_bias, norm_mix_g, w_in, a_q_norm_g, a_k_norm_g, a_sinks, b_q_norm_g,
                 b_k_norm_g, cmp_pos_emb, cmp_w1, cmp_b1, cmp_w2, cmp_b2, out_norm_g, w_out,
                 norm_ffn_g, w_gate, w_up, conv_w, conv_b, w_down):
    B, S, _ = x.shape
    hn = rms_norm(x, norm_mix_g)
    proj = hn @ w_in
    splits = np.cumsum(IN_SIZES)[:-1].tolist()
    aq, ak, av, bq, bkc, bvc, bks, bvs, bkw, bvw, bg = jnp.split(proj, splits, axis=-1)

    def heads(t, n):
        return t.reshape(B, S, n, HEAD_DIM)

    tab_a = rel_bias[:, :A_Q_HEADS]
    tab_b = rel_bias[:, A_Q_HEADS:]

    o_a = banded_attention(rms_norm(heads(aq, A_Q_HEADS), a_q_norm_g),
                           rms_norm(heads(ak, A_KV_HEADS), a_k_norm_g),
                           heads(av, A_KV_HEADS), tab_a, A_WINDOW, a_sinks)

    q = rms_norm(heads(bq, B_Q_HEADS), b_q_norm_g)
    kc = rms_norm(compress(heads(bkc, B_KV_HEADS), cmp_pos_emb[0], cmp_w1[0], cmp_b1[0],
                           cmp_w2[0], cmp_b2[0]), b_k_norm_g[0])
    vc = compress(heads(bvc, B_KV_HEADS), cmp_pos_emb[1], cmp_w1[1], cmp_b1[1], cmp_w2[1], cmp_b2[1])
    o_cmp, p_grp = compressed_attention(q, kc, vc, tab_b)
    sel_idx = select_blocks(p_grp, S)
    o_slc = selected_attention(q, rms_norm(heads(bks, B_KV_HEADS), b_k_norm_g[1]),
                               heads(bvs, B_KV_HEADS), sel_idx, tab_b)
    o_win = banded_attention(q, rms_norm(heads(bkw, B_KV_HEADS), b_k_norm_g[2]),
                             heads(bvw, B_KV_HEADS), tab_b, B_WINDOW, None)
    gates = jax.nn.sigmoid(bg.astype(jnp.float32)).reshape(B, S, B_Q_HEADS, N_BRANCH).astype(x.dtype)
    o_b = gates[..., 0:1] * o_cmp + gates[..., 1:2] * o_slc + gates[..., 2:3] * o_win

    o_a = rms_norm(o_a.reshape(B, S, A_WIDTH), out_norm_g[:A_WIDTH])
    o_b = rms_norm(o_b.reshape(B, S, B_WIDTH), out_norm_g[A_WIDTH:])
    x = x + jnp.concatenate([o_a, o_b], axis=-1) @ w_out

    hf = rms_norm(x, norm_ffn_g)
    g = causal_dwconv(hf @ w_gate, conv_w, conv_b)
    return x + (jax.nn.silu(g) * (hf @ w_up)) @ w_down


def setup_inputs(seed: int = 0) -> dict:
    key = jax.random.key(seed)
    ks = jax.random.split(key, 24)
    f32 = jnp.float32
    L = DEPTH

    def nrm(k, shape, scale):
        return jax.random.normal(k, shape, f32) * scale

    def gain(k, shape):
        return 1.0 + 0.05 * jax.random.normal(k, shape, f32)

    return {
        "x": nrm(ks[0], (BATCH, SEQ, D_MODEL), 1.0),
        "rel_bias": nrm(ks[1], (N_BUCKETS, MIX_HEADS), 0.5),
        "norm_mix_g": gain(ks[2], (L, D_MODEL)),
        "w_in": nrm(ks[3], (L, D_MODEL, N_IN), D_MODEL ** -0.5),
        "a_q_norm_g": gain(ks[4], (L, HEAD_DIM)),
        "a_k_norm_g": gain(ks[5], (L, HEAD_DIM)),
        "a_sinks": nrm(ks[6], (L, A_Q_HEADS), 0.5),
        "b_q_norm_g": gain(ks[7], (L, HEAD_DIM)),
        "b_k_norm_g": gain(ks[8], (L, N_BRANCH, HEAD_DIM)),
        "cmp_pos_emb": nrm(ks[9], (L, 2, CMP_BLOCK, HEAD_DIM), 0.1),
        "cmp_w1": nrm(ks[10], (L, 2, CMP_BLOCK * HEAD_DIM, CMP_HIDDEN), (CMP_BLOCK * HEAD_DIM) ** -0.5),
        "cmp_b1": nrm(ks[11], (L, 2, CMP_HIDDEN), 0.02),
        "cmp_w2": nrm(ks[12], (L, 2, CMP_HIDDEN, HEAD_DIM), CMP_HIDDEN ** -0.5),
        "cmp_b2": nrm(ks[13], (L, 2, HEAD_DIM), 0.02),
        "out_norm_g": gain(ks[14], (L, MIX_WIDTH)),
        "w_out": nrm(ks[15], (L, MIX_WIDTH, D_MODEL), MIX_WIDTH ** -0.5),
        "norm_ffn_g": gain(ks[16], (L, D_MODEL)),
        "w_gate": nrm(ks[17], (L, D_MODEL, D_FF), D_MODEL ** -0.5),
        "w_up": nrm(ks[18], (L, D_MODEL, D_FF), D_MODEL ** -0.5),
        "conv_w": nrm(ks[19], (L, CONV_WIDTH, D_FF), CONV_WIDTH ** -0.5),
        "conv_b": nrm(ks[20], (L, D_FF), 0.02),
        "w_down": nrm(ks[21], (L, D_FF, D_MODEL), D_FF ** -0.5),
    }


def reference(x, rel_bias, norm_mix_g, w_in, a_q_norm_g, a_k_norm_g, a_sinks, b_q_norm_g,
              b_k_norm_g, cmp_pos_emb, cmp_w1, cmp_b1, cmp_w2, cmp_b2, out_norm_g, w_out,
              norm_ffn_g, w_gate, w_up, conv_w, conv_b, w_down):
    h = x
    for l in range(DEPTH):
        h = hybrid_layer(h, rel_bias, norm_mix_g[l], w_in[l], a_q_norm_g[l], a_k_norm_g[l],
                         a_sinks[l], b_q_norm_g[l], b_k_norm_g[l], cmp_pos_emb[l], cmp_w1[l],
                         cmp_b1[l], cmp_w2[l], cmp_b2[l], out_norm_g[l], w_out[l], norm_ffn_g[l],
                         w_gate[l], w_up[l], conv_w[l], conv_b[l], w_down[l])
    return h
```

```cpp
#include <hip/hip_runtime.h>
#include <hip/hip_cooperative_groups.h>
#include <cstdio>
#include <cstdint>
namespace cg = cooperative_groups;
namespace pg8 {
#define PG8_LAS __attribute__((address_space(3)))
typedef unsigned short bf16_t;
typedef short bf16x8 __attribute__((ext_vector_type(8)));
typedef float f32x4 __attribute__((ext_vector_type(4)));
typedef unsigned u32x4 __attribute__((ext_vector_type(4)));
constexpr int BM = 256, BK = 64, HALF = 128, HTB = HALF * BK * 2  , STAGE_BYTES = 8 * HTB, NXCD = 8, WGM = 8;

__host__ __device__ __forceinline__ int lds_byte(int r, int c) { const int st = (r >> 4) * 2 + (c >> 5), rr = r & 15, cc = c & 31, ob = rr * 64 + cc * 2; return st * 1024 + (ob ^ (((ob >> 9) & 1) << 5)); }
__host__ __device__ __forceinline__ void stage_rc(int b, int& R, int& C) { const int st = b / 1024, sb = b % 1024, swz = sb ^ (((sb >> 9) & 1) << 5); R = (st >> 1) * 16 + swz / 64; C = (st & 1) * 32 + (swz % 64) / 2; }
__host__ __device__ __forceinline__ int perm32(int rho) { const int n = rho >> 4, i = rho & 15; return 8 * (i >> 2) + 4 * n + (i & 3); }

struct Unit { int pm, pn; };
struct Gemm { const bf16_t* A; const bf16_t* Bt; int M, N, K; };

struct StaticOrder {
    int nM, nN, nwg, G, c;
    __host__ __device__ void init(int M, int N, int G_, int c_) { nM = M / BM; nN = N / BM; nwg = nM * nN; G = G_; c = c_; }
    __host__ __device__ bool next(int i, Unit& u) const {
        const long L = (long)i * G + c; if (L >= nwg) return false;
        int wgid = (int)L; { const int q = nwg / NXCD, r = nwg % NXCD, xcd = wgid % NXCD, off = wgid / NXCD; wgid = (xcd < r ? xcd * (q + 1) : r * (q + 1) + (xcd - r) * q) + off; }
        const int nig = WGM * nN, gid = wgid / nig, fm = gid * WGM, gsz = (nM - fm) < WGM ? (nM - fm) : WGM;
        u.pm = fm + ((wgid % nig) % gsz); u.pn = (wgid % nig) / gsz; return true;
    }
    __device__ __forceinline__ void a_ready(const Unit&) const {}
    __device__ __forceinline__ void done(const Unit&) const {}
};
__device__ __forceinline__ unsigned cvt_pk_bf16(float lo, float hi) { unsigned r; asm volatile("v_cvt_pk_bf16_f32 %0, %1, %2" : "=v"(r) : "v"(lo), "v"(hi)); return r; }
template <class Epi, class Sched, bool STAMP = false>
__device__ __forceinline__ void gemm_phase(PG8_LAS unsigned char* lds, const Gemm g, const Sched& S, const Epi& E, unsigned long long* stamps) {
    const int tid = threadIdx.x, wid = __builtin_amdgcn_readfirstlane(tid >> 6), lane = tid & 63, wr = wid >> 2, wc = wid & 3, fr = lane & 15, fq = lane >> 4;
    const int K = g.K, nt = K / BK;
    int ts_lo = 0, ts_hi = 0, nts = 0; const unsigned long long rt_entry = STAMP ? (unsigned long long)wall_clock64() : 0ull;
#define PG8_STAMP() do { if (STAMP && wid == 0 && nts < 64) { const unsigned long long _c = (unsigned long long)clock64(); \
        ts_lo = (lane == nts) ? (int)(unsigned)_c : ts_lo; ts_hi = (lane == nts) ? (int)(unsigned)(_c >> 32) : ts_hi; ++nts; } } while (0)
    PG8_STAMP();
    unsigned voffA[2], voffB[2];
#pragma unroll
    for (int i = 0; i < 2; ++i) { int R, C; stage_rc(tid * 16 + i * 8192, R, C); const int Rb = Epi::PERM ? ((R & ~31) + perm32(R & 31)) : R;
        voffA[i] = (unsigned)(R * K + C) * 2u; voffB[i] = (unsigned)(Rb * K + C) * 2u; }
    const size_t kstep = (size_t)(BK * 2);
    const size_t hstep = (size_t)HALF * K * 2;
    const size_t tstep = 2 * hstep;
    const unsigned ldsw = (unsigned)wid * 1024u;
    const int aoff = lds_byte(wr * 64 + fr, fq * 8), boff = lds_byte(wc * 32 + fr, fq * 8);
#define PG8_SA(b, h) (((b) * 2 + (h)) * HTB)
#define PG8_SB(b, h) ((4 + (b) * 2 + (h)) * HTB)
#define PG8_STAGE(bufoff, gbase, voff) do { _Pragma("unroll") for (int _i = 0; _i < 2; ++_i) \
        __builtin_amdgcn_global_load_lds((const unsigned*)((const char*)(gbase) + (voff)[_i]), (PG8_LAS unsigned*)(lds + (bufoff) + ldsw + _i * 8192), 16, 0, 0); } while (0)
#define PG8_LDA(dst, b, h) do { _Pragma("unroll") for (int m = 0; m < 4; ++m) _Pragma("unroll") for (int k = 0; k < 2; ++k) dst[m][k] = *(const PG8_LAS bf16x8*)(lds + PG8_SA(b, h) + aoff + m * 2048 + k * 1024); } while (0)
#define PG8_LDB(dst, b, h) do { _Pragma("unroll") for (int n = 0; n < 2; ++n) _Pragma("unroll") for (int k = 0; k < 2; ++k) dst[n][k] = *(const PG8_LAS bf16x8*)(lds + PG8_SB(b, h) + boff + n * 2048 + k * 1024); } while (0)
#define PG8_MMA(ai, bj, At, Bt) do { __builtin_amdgcn_s_setprio(1); _Pragma("unroll") for (int m = 0; m < 4; ++m) _Pragma("unroll") for (int n = 0; n < 2; ++n) _Pragma("unroll") for (int k = 0; k < 2; ++k) \
        acc[ai][bj][m][n] = __builtin_amdgcn_mfma_f32_16x16x32_bf16(Bt[n][k], At[m][k], acc[ai][bj][m][n], 0, 0, 0); __builtin_amdgcn_s_setprio(0); } while (0)
#define PG8_WAIT_V(n) asm volatile("s_waitcnt vmcnt(" #n ")" ::: "memory")
#define PG8_WAIT_L(n) asm volatile("s_waitcnt lgkmcnt(" #n ")" ::: "memory")
#define PG8_BAR __builtin_amdgcn_s_barrier()
#define PG8_SCHED __builtin_amdgcn_sched_barrier(0)
    Unit cur, nxt; int ui = 0;
    if (!S.next(0, cur)) return;
    f32x4 acc[2][2][4][2];
#pragma unroll
    for (int a = 0; a < 2; ++a)
#pragma unroll
        for (int b = 0; b < 2; ++b)
#pragma unroll
            for (int m = 0; m < 4; ++m)
#pragma unroll
                for (int n = 0; n < 2; ++n) acc[a][b][m][n] = (f32x4){0.f, 0.f, 0.f, 0.f};
    bf16x8 At[4][2], B0[2][2], B1[2][2];
    const char* cA = (const char*)g.A + (size_t)cur.pm * tstep; const char* cB = (const char*)g.Bt + (size_t)cur.pn * tstep;
    S.a_ready(cur);
    PG8_STAGE(PG8_SB(0, 0), cB, voffB); PG8_STAGE(PG8_SA(0, 0), cA, voffA); PG8_STAGE(PG8_SB(0, 1), cB + hstep, voffB); PG8_STAGE(PG8_SA(0, 1), cA + hstep, voffA);
    if (wr == 1) PG8_BAR;
    PG8_WAIT_V(4); PG8_BAR;
    PG8_STAGE(PG8_SB(1, 0), cB + kstep, voffB); PG8_STAGE(PG8_SA(1, 0), cA + kstep, voffA); PG8_STAGE(PG8_SB(1, 1), cB + hstep + kstep, voffB);
    PG8_WAIT_V(6); PG8_BAR;
    PG8_STAMP();
    for (;;) {
        const bool has_next = S.next(ui + 1, nxt);
        const char* nA = has_next ? (const char*)g.A + (size_t)nxt.pm * tstep : cA; const char* nB = has_next ? (const char*)g.Bt + (size_t)nxt.pn * tstep : cB;
        for (int t = 0; t < nt; t += 2) {
            const bool last = (t == nt - 2);
            const char* a1 = cA + (size_t)(t + 1) * kstep;
            const char* a2 = last ? nA : cA + (size_t)(t + 2) * kstep; const char* b2 = last ? nB : cB + (size_t)(t + 2) * kstep;
            const char* a3 = a2 + kstep; const char* b3 = b2 + kstep;
            if (last && has_next) S.a_ready(nxt);
            PG8_LDB(B0, 0, 0); PG8_SCHED; PG8_LDA(At, 0, 0); PG8_STAGE(PG8_SA(1, 1), a1 + hstep, voffA);
            PG8_WAIT_L(8); PG8_BAR; PG8_WAIT_L(0); PG8_MMA(0, 0, At, B0); PG8_BAR; PG8_SCHED;
            PG8_LDB(B1, 0, 1); PG8_STAGE(PG8_SB(0, 0), b2, voffB);
            PG8_BAR; PG8_WAIT_L(0); PG8_MMA(0, 1, At, B1); PG8_BAR;
            PG8_LDA(At, 0, 1); PG8_STAGE(PG8_SA(0, 0), a2, voffA);
            PG8_BAR; PG8_WAIT_L(0); PG8_MMA(1, 0, At, B0); PG8_BAR; PG8_SCHED;
            PG8_STAGE(PG8_SB(0, 1), b2 + hstep, voffB);
            PG8_WAIT_V(6); PG8_BAR; PG8_MMA(1, 1, At, B1); PG8_BAR;
            PG8_LDB(B0, 1, 0); PG8_SCHED; PG8_LDA(At, 1, 0); PG8_STAGE(PG8_SA(0, 1), a2 + hstep, voffA);
            PG8_WAIT_L(8); PG8_BAR; PG8_WAIT_L(0); PG8_MMA(0, 0, At, B0); PG8_BAR; PG8_SCHED;
            PG8_LDB(B1, 1, 1); PG8_STAGE(PG8_SB(1, 0), b3, voffB);
            PG8_BAR; PG8_WAIT_L(0); PG8_MMA(0, 1, At, B1); PG8_BAR;
            PG8_LDA(At, 1, 1); PG8_STAGE(PG8_SA(1, 0), a3, voffA);
            PG8_BAR; PG8_WAIT_L(0); PG8_MMA(1, 0, At, B0); PG8_BAR; PG8_SCHED;
            PG8_STAGE(PG8_SB(1, 1), b3 + hstep, voffB);
            PG8_WAIT_V(6); PG8_BAR; PG8_MMA(1, 1, At, B1); PG8_BAR;
        }
        PG8_STAMP();
        if constexpr (!Epi::AFTER_DRAIN) { E(acc, cur, wr, wc, fr, fq); S.done(cur); }
        PG8_STAMP();
        if (!has_next) break;
#pragma unroll
        for (int a = 0; a < 2; ++a)
#pragma unroll
            for (int b = 0; b < 2; ++b)
#pragma unroll
                for (int m = 0; m < 4; ++m)
#pragma unroll
                    for (int n = 0; n < 2; ++n) acc[a][b][m][n] = (f32x4){0.f, 0.f, 0.f, 0.f};
        cur = nxt; cA = nA; cB = nB; ++ui;
    }
    PG8_WAIT_V(0);
    if (wr == 0) PG8_BAR;
    PG8_BAR;
    if constexpr (Epi::AFTER_DRAIN) { E.fused(acc, cur, wr, wc, fr, fq, lds, wid, lane); S.done(cur); }
    PG8_STAMP();
    if (STAMP && wid == 0) { stamps[lane] = lane < nts ? (((unsigned long long)(unsigned)ts_hi << 32) | (unsigned)ts_lo) : 0ull;
        if (lane == 62) stamps[62] = rt_entry; if (lane == 63) stamps[63] = (unsigned long long)wall_clock64(); }
#undef PG8_STAMP
#undef PG8_SA
#undef PG8_SB
#undef PG8_STAGE
#undef PG8_LDA
#undef PG8_LDB
#undef PG8_MMA
#undef PG8_WAIT_V
#undef PG8_WAIT_L
#undef PG8_BAR
#undef PG8_SCHED
}
}

#define LAS __attribute__((address_space(3)))
typedef unsigned short bf16_t;
typedef short bf16x8 __attribute__((ext_vector_type(8)));
typedef float f32x4 __attribute__((ext_vector_type(4)));
typedef unsigned u32x4 __attribute__((ext_vector_type(4)));
typedef unsigned u32x2 __attribute__((ext_vector_type(2)));
using pg8::cvt_pk_bf16;

constexpr int S_ = 8192, DM = 4096, NIN = 8240, NINP = 8448, DFF = 11008, NGU = 22016;
constexpr float EPS_ = 1e-6f;
constexpr float LOG2E = 1.4426950408889634f;
constexpr float QSCALE = 0.08838834764831845f * 1.4426950408889634f;
constexpr int LDS_BYTES = 131072;

constexpr size_t SZ_WGU = (size_t)NGU * DM * 2, SZ_WD = (size_t)DM * DFF * 2, SZ_WOUT = (size_t)DM * DM * 2, SZ_W1 = 512ull * 4096 * 2, SZ_SMALL = 1u << 20;
constexpr size_t OFF_WGU = 0, OFF_WD = OFF_WGU + SZ_WGU, OFF_WOUT = OFF_WD + SZ_WD, OFF_W1 = OFF_WOUT + SZ_WOUT, OFF_SMALL = OFF_W1 + SZ_W1;
constexpr size_t OFF_RSTD0 = OFF_SMALL, OFF_SS1 = OFF_SMALL + 32768, OFF_B1PART = OFF_SMALL + 65536, OFF_B1P = OFF_SMALL + 131072;
constexpr size_t OFF_C = OFF_SMALL + SZ_SMALL;
constexpr size_t SZ_Q = (size_t)S_ * 2048 * 2, SZ_KV = (size_t)S_ * 512 * 2;
constexpr size_t OFF_QA = OFF_C, OFF_QB = OFF_QA + SZ_Q, OFF_KA = OFF_QB + SZ_Q, OFF_KS = OFF_KA + SZ_KV, OFF_KW = OFF_KS + SZ_KV;
constexpr size_t OFF_VA = OFF_KW + SZ_KV, OFF_VS = OFF_VA + SZ_KV, OFF_VW = OFF_VS + SZ_KV;
constexpr size_t OFF_GATES = OFF_VW + SZ_KV, SZ_GATES = (size_t)S_ * 48 * 4;
constexpr size_t OFF_IM2 = OFF_GATES + SZ_GATES, SZ_IM2 = 4096ull * 4096 * 2;
constexpr size_t OFF_H = OFF_IM2 + SZ_IM2, SZ_H = 4096ull * 256 * 2;
constexpr size_t OFF_KC = OFF_H + SZ_H, SZ_KC = 4ull * 512 * 128 * 2;
constexpr size_t OFF_VCT = OFF_KC + SZ_KC;
constexpr size_t OFF_SEL = OFF_VCT + SZ_KC, SZ_SEL = 4ull * S_ * 16;
constexpr size_t OFF_B = OFF_SEL + SZ_SEL;
constexpr size_t SZ_WIN = (size_t)NINP * DM * 2, SZ_XB = (size_t)S_ * DM * 2, SZ_PROJ = (size_t)S_ * NINP * 2;
constexpr size_t OFF_WIN = OFF_B, OFF_XB = OFF_WIN + SZ_WIN, OFF_PROJ = OFF_XB + SZ_XB, WS_END = OFF_PROJ + SZ_PROJ;
constexpr size_t OFF_GU = OFF_C, SZ_GU = (size_t)S_ * NGU * 2;
constexpr size_t OFF_X1B = OFF_PROJ + SZ_PROJ - SZ_XB;
constexpr size_t OFF_ON = OFF_WIN;
constexpr size_t OFF_HF = OFF_WGU;
static_assert(OFF_X1B >= OFF_GU + SZ_GU, "x1b overlaps GU");
static_assert(SZ_XB <= SZ_WIN, "o_n overlay");
static_assert((size_t)S_ * DFF * 2 == SZ_WGU, "h overlay");

struct Params {
    const float *x, *rel_bias, *norm_mix_g, *w_in, *a_q_g, *a_k_g, *a_sinks, *b_q_g, *b_k_g, *pos_emb, *cmp_w1, *cmp_b1, *cmp_w2, *cmp_b2,
        *out_norm_g, *w_out, *norm_ffn_g, *w_gate, *w_up, *conv_w, *conv_b, *w_down;
    float* out;
    unsigned char* ws;
    int ph_lo, ph_hi;
};

__device__ __forceinline__ float bf_lo(unsigned w) { return __uint_as_float(w << 16); }
__device__ __forceinline__ float bf_hi(unsigned w) { return __uint_as_float(w & 0xffff0000u); }
__device__ __forceinline__ float wave_sum(float v) {
#pragma unroll
    for (int o = 32; o >= 1; o >>= 1) v += __shfl_xor(v, o);
    return v;
}
__constant__ unsigned char T5B[132] = {0, 1, 2, 3, 4, 5, 6, 7, 8, 9, 10, 11, 12, 13, 14, 15, 16, 16, 16, 17, 17, 18, 18, 18, 19, 19, 19, 20, 20, 20, 20, 21, 21, 21, 21, 22, 22, 22, 22, 22, 23, 23, 23, 23, 23, 23, 24, 24, 24, 24, 24, 24, 25, 25, 25, 25, 25, 25, 25, 26, 26, 26, 26, 26, 26, 26, 26, 27, 27, 27, 27, 27, 27, 27, 27, 27, 27, 28, 28, 28, 28, 28, 28, 28, 28, 28, 28, 29, 29, 29, 29, 29, 29, 29, 29, 29, 29, 29, 29, 30, 30, 30, 30, 30, 30, 30, 30, 30, 30, 30, 30, 30, 30, 31, 31, 31, 31, 31, 31, 31, 31, 31, 31, 31, 31, 31, 31, 31, 31, 31, 31, 31};

struct EpiBf16Scale {
    static constexpr bool PERM = true, AFTER_DRAIN = false;
    bf16_t* O; int ldc; const float* rs; int mode;
    __device__ __forceinline__ void operator()(const f32x4 (&acc)[2][2][4][2], const pg8::Unit& u, int wr, int wc, int fr, int fq) const {
        const int row0 = u.pm * 256 + wr * 64 + fr, col0 = u.pn * 256 + wc * 32 + 8 * fq;
#pragma unroll
        for (int ai = 0; ai < 2; ++ai)
#pragma unroll
            for (int m = 0; m < 4; ++m) {
                const int row = row0 + ai * 128 + m * 16;
                float sc = rs[row]; if (mode) sc = rsqrtf(sc * (1.0f / 4096.0f) + EPS_);
                bf16_t* rowp = O + (size_t)row * ldc + col0;
#pragma unroll
                for (int bj = 0; bj < 2; ++bj) { const f32x4 v0 = acc[ai][bj][m][0] * sc, v1 = acc[ai][bj][m][1] * sc;
                    u32x4 w; w.x = cvt_pk_bf16(v0[0], v0[1]); w.y = cvt_pk_bf16(v0[2], v0[3]); w.z = cvt_pk_bf16(v1[0], v1[1]); w.w = cvt_pk_bf16(v1[2], v1[3]);
                    *(u32x4*)(rowp + bj * 128) = w; }
            }
    }
};
struct EpiCmp {
    static constexpr bool PERM = true, AFTER_DRAIN = false;
    bf16_t* H; const float* b1p;
    __device__ __forceinline__ void operator()(const f32x4 (&acc)[2][2][4][2], const pg8::Unit& u, int wr, int wc, int fr, int fq) const {
        if ((u.pm >> 3) != u.pn) return;
        const int row0 = u.pm * 256 + wr * 64 + fr, colL = wc * 32 + 8 * fq;
#pragma unroll
        for (int bj = 0; bj < 2; ++bj) {
            const f32x4 b0 = *(const f32x4*)(b1p + u.pn * 256 + colL + bj * 128), b1 = *(const f32x4*)(b1p + u.pn * 256 + colL + bj * 128 + 4);
#pragma unroll
            for (int ai = 0; ai < 2; ++ai)
#pragma unroll
                for (int m = 0; m < 4; ++m) {
                    const int row = row0 + ai * 128 + m * 16;
                    f32x4 v0 = acc[ai][bj][m][0] + b0, v1 = acc[ai][bj][m][1] + b1;
#pragma unroll
                    for (int j = 0; j < 4; ++j) {
                        float a = v0[j]; v0[j] = a / (1.0f + __expf(-1.5957691216057308f * (a + 0.044715f * a * a * a)));
                        float b = v1[j]; v1[j] = b / (1.0f + __expf(-1.5957691216057308f * (b + 0.044715f * b * b * b))); }
                    u32x4 w; w.x = cvt_pk_bf16(v0[0], v0[1]); w.y = cvt_pk_bf16(v0[2], v0[3]); w.z = cvt_pk_bf16(v1[0], v1[1]); w.w = cvt_pk_bf16(v1[2], v1[3]);
                    *(u32x4*)(H + (size_t)row * 256 + colL + bj * 128) = w;
                }
        }
    }
};
struct EpiOutProj {
    static constexpr bool PERM = false, AFTER_DRAIN = false;
    const float* x; float* out; bf16_t* x1b; float* ss1;
    __device__ __forceinline__ void operator()(const f32x4 (&acc)[2][2][4][2], const pg8::Unit& u, int wr, int wc, int fr, int fq) const {
        const int row0 = u.pm * 256 + wr * 64 + fr, col0 = u.pn * 256 + wc * 32 + 4 * fq;
#pragma unroll
        for (int ai = 0; ai < 2; ++ai)
#pragma unroll
            for (int m = 0; m < 4; ++m) {
                const int row = row0 + ai * 128 + m * 16; const size_t off = (size_t)row * DM + col0; float ss = 0.f;
#pragma unroll
                for (int bj = 0; bj < 2; ++bj)
#pragma unroll
                    for (int n = 0; n < 2; ++n) { const f32x4 xv = *(const f32x4*)(x + off + bj * 128 + n * 16); const f32x4 o = xv + acc[ai][bj][m][n];
                        *(f32x4*)(out + off + bj * 128 + n * 16) = o;
                        u32x2 w; w.x = cvt_pk_bf16(o[0], o[1]); w.y = cvt_pk_bf16(o[2], o[3]); *(u32x2*)(x1b + off + bj * 128 + n * 16) = w;
                        ss += (o[0] * o[0] + o[1] * o[1]) + (o[2] * o[2] + o[3] * o[3]); }
                ss += __shfl_xor(ss, 16); ss += __shfl_xor(ss, 32);
                if (fq == 0) atomicAdd(ss1 + row, ss);
            }
    }
};
struct EpiDown {
    static constexpr bool PERM = false, AFTER_DRAIN = false;
    float* out;
    __device__ __forceinline__ void operator()(const f32x4 (&acc)[2][2][4][2], const pg8::Unit& u, int wr, int wc, int fr, int fq) const {
        const int row0 = u.pm * 256 + wr * 64 + fr, col0 = u.pn * 256 + wc * 32 + 4 * fq;
#pragma unroll
        for (int ai = 0; ai < 2; ++ai)
#pragma unroll
            for (int m = 0; m < 4; ++m) {
                const size_t off = (size_t)(row0 + ai * 128 + m * 16) * DM + col0;
#pragma unroll
                for (int bj = 0; bj < 2; ++bj)
#pragma unroll
                    for (int n = 0; n < 2; ++n) { float* p = out + off + bj * 128 + n * 16; *(f32x4*)p = *(const f32x4*)p + acc[ai][bj][m][n]; }
            }
    }
};

__device__ __forceinline__ void tconv_tile(unsigned* ldsw, const float* __restrict__ src, int K, int N, bf16_t* __restrict__ dst, const float* __restrict__ gain, int kt, int nt) {
    const int t = threadIdx.x, n4 = (t & 31) * 4, kp = t >> 5, k0 = kt * 64, n0 = nt * 128;
#pragma unroll
    for (int i = 0; i < 2; ++i) {
        const int kk = 2 * (kp + 16 * i);
        f32x4 a = {0.f, 0.f, 0.f, 0.f}, b = {0.f, 0.f, 0.f, 0.f};
        if (n0 + n4 < N) { a = *(const f32x4*)(src + (size_t)(k0 + kk) * N + n0 + n4); b = *(const f32x4*)(src + (size_t)(k0 + kk + 1) * N + n0 + n4); }
        if (gain) { a = a * gain[k0 + kk]; b = b * gain[k0 + kk + 1]; }
#pragma unroll
        for (int j = 0; j < 4; ++j) ldsw[(n4 + j) * 33 + kp + 16 * i] = cvt_pk_bf16(a[j], b[j]);
    }
    __syncthreads();
    const int n = t >> 2, c = t & 3;
    u32x4 w0, w1;
    w0.x = ldsw[n * 33 + c * 8 + 0]; w0.y = ldsw[n * 33 + c * 8 + 1]; w0.z = ldsw[n * 33 + c * 8 + 2]; w0.w = ldsw[n * 33 + c * 8 + 3];
    w1.x = ldsw[n * 33 + c * 8 + 4]; w1.y = ldsw[n * 33 + c * 8 + 5]; w1.z = ldsw[n * 33 + c * 8 + 6]; w1.w = ldsw[n * 33 + c * 8 + 7];
    bf16_t* d = dst + (size_t)(n0 + n) * K + k0 + c * 16;
    *(u32x4*)d = w0; *(u32x4*)(d + 8) = w1;
    __syncthreads();
}

__device__ void phase_prep(const Params& P, unsigned char* shm) {
    unsigned* ldsw = (unsigned*)shm;
    unsigned char* ws = P.ws;
    const int tid = threadIdx.x, wid = tid >> 6, lane = tid & 63;
    for (int i = blockIdx.x * 512 + tid; i < S_; i += gridDim.x * 512) ((float*)(ws + OFF_SS1))[i] = 0.f;
    for (int it = blockIdx.x; it < 64; it += gridDim.x) {
        const int c = it >> 5, kc = it & 31;
        if (tid < 256) { const float* pe = P.pos_emb + (size_t)c * 4096 + kc * 128; const float* w = P.cmp_w1 + ((size_t)c * 4096 + kc * 128) * 256 + tid; float s = 0.f;
            for (int k = 0; k < 128; ++k) s += pe[k] * w[(size_t)k * 256];
            ((float*)(ws + OFF_B1PART))[(c * 32 + kc) * 256 + tid] = s; }
    }
    for (int row = blockIdx.x * 8 + wid; row < S_; row += gridDim.x * 8) {
        const f32x4* xr = (const f32x4*)(P.x + (size_t)row * DM); bf16_t* xo = (bf16_t*)(ws + OFF_XB) + (size_t)row * DM; float ss = 0.f;
#pragma unroll 4
        for (int i = 0; i < 16; ++i) { const f32x4 v = xr[i * 64 + lane]; ss += (v[0] * v[0] + v[1] * v[1]) + (v[2] * v[2] + v[3] * v[3]);
            u32x2 w; w.x = cvt_pk_bf16(v[0], v[1]); w.y = cvt_pk_bf16(v[2], v[3]); *(u32x2*)(xo + (i * 64 + lane) * 4) = w; }
        ss = wave_sum(ss);
        if (lane == 0) ((float*)(ws + OFF_RSTD0))[row] = rsqrtf(ss * (1.0f / 4096.0f) + EPS_);
    }
    constexpr int J0 = 64 * 66, J1 = J0 + 64 * 32, J2 = J1 + 64 * 86, J3 = J2 + 64 * 86, J4 = J3 + 172 * 32, J5 = J4 + 128, J6 = J5 + 128;
    for (int it = blockIdx.x; it < J6; it += gridDim.x) {
        if (it < J0) { tconv_tile(ldsw, P.w_in, 4096, NIN, (bf16_t*)(ws + OFF_WIN), P.norm_mix_g, it / 66, it % 66); }
        else if (it < J1) { const int i = it - J0; tconv_tile(ldsw, P.w_out, 4096, 4096, (bf16_t*)(ws + OFF_WOUT), P.out_norm_g, i / 32, i % 32); }
        else if (it < J2) { const int i = it - J1; tconv_tile(ldsw, P.w_gate, 4096, DFF, (bf16_t*)(ws + OFF_WGU), P.norm_ffn_g, i / 86, i % 86); }
        else if (it < J3) { const int i = it - J2; tconv_tile(ldsw, P.w_up, 4096, DFF, (bf16_t*)(ws + OFF_WGU) + (size_t)DFF * DM, P.norm_ffn_g, i / 86, i % 86); }
        else if (it < J4) { const int i = it - J3; tconv_tile(ldsw, P.w_down, DFF, 4096, (bf16_t*)(ws + OFF_WD), nullptr, i / 32, i % 32); }
        else if (it < J5) { const int i = it - J4; tconv_tile(ldsw, P.cmp_w1, 4096, 256, (bf16_t*)(ws + OFF_W1), nullptr, i / 2, i % 2); }
        else { const int i = it - J5; tconv_tile(ldsw, P.cmp_w1 + 4096 * 256, 4096, 256, (bf16_t*)(ws + OFF_W1) + 256 * 4096, nullptr, i / 2, i % 2); }
    }
}

__device__ __forceinline__ void norm_head(const bf16_t* src, bf16_t* dst, float g0, float g1, float scale, int lane) {
    const unsigned w = *(const unsigned*)(src + 2 * lane); float a = bf_lo(w), b = bf_hi(w);
    const float ss = wave_sum(a * a + b * b); const float r = rsqrtf(ss * (1.0f / 128.0f) + EPS_) * scale;
    *(unsigned*)(dst + 2 * lane) = cvt_pk_bf16(a * r * g0, b * r * g1);
}
__device__ void phase_norm(const Params& P, unsigned char* shm) {
    unsigned char* ws = P.ws; const bf16_t* proj = (const bf16_t*)(ws + OFF_PROJ);
    const int tid = threadIdx.x, wid = tid >> 6, lane = tid & 63;
    {
        bf16_t* T = (bf16_t*)shm;
        for (int it = blockIdx.x; it < 384; it += gridDim.x) {
            const int v = it >> 7, sb = it & 127, s0 = sb * 64;
            const int col = v == 0 ? 2560 : (v == 1 ? 6656 : 7680);
            bf16_t* dst = (bf16_t*)(ws + (v == 0 ? OFF_VA : (v == 1 ? OFF_VS : OFF_VW)));
#pragma unroll
            for (int i = 0; i < 8; ++i) { const int r = (tid >> 6) + 8 * i, ch = tid & 63;
                *(u32x4*)(T + r * 520 + ch * 8) = *(const u32x4*)(proj + (size_t)(s0 + r) * NINP + col + ch * 8); }
            __syncthreads();
#pragma unroll
            for (int k = 0; k < 8; ++k) { unsigned w[4];
#pragma unroll
                for (int e = 0; e < 4; ++e) w[e] = (unsigned)T[(8 * k + 2 * e) * 520 + tid] | ((unsigned)T[(8 * k + 2 * e + 1) * 520 + tid] << 16);
                u32x4 o; o.x = w[0]; o.y = w[1]; o.z = w[2]; o.w = w[3];
                *(u32x4*)(dst + (size_t)tid * S_ + s0 + 8 * k) = o; }
            __syncthreads();
        }
    }
    {
        const float aq0 = P.a_q_g[2 * lane], aq1 = P.a_q_g[2 * lane + 1], ak0 = P.a_k_g[2 * lane], ak1 = P.a_k_g[2 * lane + 1];
        const float bq0 = P.b_q_g[2 * lane], bq1 = P.b_q_g[2 * lane + 1];
        const float ks0 = P.b_k_g[128 + 2 * lane], ks1 = P.b_k_g[128 + 2 * lane + 1], kw0 = P.b_k_g[256 + 2 * lane], kw1 = P.b_k_g[256 + 2 * lane + 1];
        for (int s = blockIdx.x * 8 + wid; s < S_; s += gridDim.x * 8) {
            const bf16_t* pr = proj + (size_t)s * NINP;
            bf16_t* qa = (bf16_t*)(ws + OFF_QA) + (size_t)s * 2048; bf16_t* qb = (bf16_t*)(ws + OFF_QB) + (size_t)s * 2048;
            for (int h = 0; h < 16; ++h) norm_head(pr + h * 128, qa + h * 128, aq0, aq1, QSCALE, lane);
            for (int h = 0; h < 16; ++h) norm_head(pr + 3072 + h * 128, qb + h * 128, bq0, bq1, QSCALE, lane);
            for (int h = 0; h < 4; ++h) {
                norm_head(pr + 2048 + h * 128, (bf16_t*)(ws + OFF_KA) + (size_t)s * 512 + h * 128, ak0, ak1, 1.0f, lane);
                norm_head(pr + 6144 + h * 128, (bf16_t*)(ws + OFF_KS) + (size_t)s * 512 + h * 128, ks0, ks1, 1.0f, lane);
                norm_head(pr + 7168 + h * 128, (bf16_t*)(ws + OFF_KW) + (size_t)s * 512 + h * 128, kw0, kw1, 1.0f, lane);
            }
            if (lane < 48) { const float v = __uint_as_float(((unsigned)pr[8192 + lane]) << 16); ((float*)(ws + OFF_GATES))[s * 48 + lane] = 1.0f / (1.0f + __expf(-v)); }
        }
    }
    {
        bf16_t* im = (bf16_t*)(ws + OFF_IM2);
        for (int r = blockIdx.x * 8 + wid; r < 4096; r += gridDim.x * 8) {
            const int c = r >> 11, g = (r >> 9) & 3, n = r & 511, colc = (c ? 5632 : 5120) + g * 128;
            const int sub = lane >> 4, ch = lane & 15;
#pragma unroll
            for (int itx = 0; itx < 8; ++itx) { const int l = itx * 4 + sub; u32x4 v = {0u, 0u, 0u, 0u};
                if (n < 511) v = *(const u32x4*)(proj + (size_t)(16 * n + l) * NINP + colc + ch * 8);
                *(u32x4*)(im + (size_t)r * 4096 + l * 128 + ch * 8) = v; }
        }
    }
    if (blockIdx.x == gridDim.x - 1) { const int c = tid >> 8, n = tid & 255; float s = P.cmp_b1[tid];
        for (int kc = 0; kc < 32; ++kc) s += ((const float*)(ws + OFF_B1PART))[(c * 32 + kc) * 256 + n];
        ((float*)(ws + OFF_B1P))[tid] = s; }
}

__device__ void phase_cmp2(const Params& P) {
    unsigned char* ws = P.ws; const int tid = threadIdx.x, wid = tid >> 6, lane = tid & 63;
    const bf16_t* H = (const bf16_t*)(ws + OFF_H);
    for (int r = blockIdx.x * 8 + wid; r < 4096; r += gridDim.x * 8) {
        const int c = r >> 11, g = (r >> 9) & 3, n = r & 511;
        const float* w2 = P.cmp_w2 + (size_t)c * 256 * 128 + 2 * lane; const bf16_t* hr = H + (size_t)r * 256;
        float a0 = P.cmp_b2[c * 128 + 2 * lane], a1 = P.cmp_b2[c * 128 + 2 * lane + 1];
#pragma unroll 8
        for (int k = 0; k < 256; ++k) { const float h = __uint_as_float(((unsigned)hr[k]) << 16); const float2 w = *(const float2*)(w2 + (size_t)k * 128); a0 += h * w.x; a1 += h * w.y; }
        if (c == 0) { const float ss = wave_sum(a0 * a0 + a1 * a1); const float rr = rsqrtf(ss * (1.0f / 128.0f) + EPS_);
            *(unsigned*)((bf16_t*)(ws + OFF_KC) + ((size_t)g * 512 + n) * 128 + 2 * lane) = cvt_pk_bf16(a0 * rr * P.b_k_g[2 * lane], a1 * rr * P.b_k_g[2 * lane + 1]); }
        else { bf16_t* vt = (bf16_t*)(ws + OFF_VCT) + ((size_t)g * 128 + 2 * lane) * 512 + n; const unsigned w = cvt_pk_bf16(a0, a1); vt[0] = (bf16_t)(w & 0xffff); vt[512] = (bf16_t)(w >> 16); }
    }
}

constexpr int AL_K = 0, AL_V = 17408, AL_BIAS = 35840, AL_SC = 38400, AL_FS = 103936;
#define NEG_INF (-__builtin_inff())

template <int MODE, int PASS>
__device__ __forceinline__ void attn_tiles(unsigned char* shm, const bf16_t* kbase, int kstride, const bf16_t* vbase, int vstride, int kt_lo, int kt_hi,
                                           const bf16x8 (&qf)[2][4], float (&m_)[2], float (&l_)[2], const float (&inv2)[2], f32x4 (&O)[2][8],
                                           unsigned sm0, unsigned sm1, unsigned sm2, unsigned sm3, int query, int hp, int qs) {
    const int tid = threadIdx.x, lane = tid & 63, n = lane & 15, qq = lane >> 4;
    const float* biasL = (const float*)(shm + AL_BIAS);
    float carry = 0.f;
    u32x4 kreg[2], vreg[2];
    {
        const int key0 = kt_lo * 64;
#pragma unroll
        for (int i = 0; i < 2; ++i) { kreg[i] = *(const u32x4*)(kbase + (size_t)(key0 + (tid >> 4) + 32 * i) * kstride + (tid & 15) * 8);
                                      vreg[i] = *(const u32x4*)(vbase + (size_t)((tid >> 3) + 64 * i) * vstride + key0 + (tid & 7) * 8); }
    }
#pragma unroll 1
    for (int kt = kt_lo; kt <= kt_hi; ++kt) {
        __syncthreads();
#pragma unroll
        for (int i = 0; i < 2; ++i) { *(u32x4*)(shm + AL_K + ((tid >> 4) + 32 * i) * 272 + (tid & 15) * 16) = kreg[i];
                                      *(u32x4*)(shm + AL_V + ((tid >> 3) + 64 * i) * 144 + (tid & 7) * 16) = vreg[i]; }
        __syncthreads();
        if (kt < kt_hi) {
            const int key0 = (kt + 1) * 64;
#pragma unroll
            for (int i = 0; i < 2; ++i) { kreg[i] = *(const u32x4*)(kbase + (size_t)(key0 + (tid >> 4) + 32 * i) * kstride + (tid & 15) * 8);
                                          vreg[i] = *(const u32x4*)(vbase + (size_t)((tid >> 3) + 64 * i) * vstride + key0 + (tid & 7) * 8); }
        }
        const int key0 = kt * 64;
        bool selb = true;
        if (MODE == 3) { const unsigned w = kt < 32 ? sm0 : (kt < 64 ? sm1 : (kt < 96 ? sm2 : sm3)); selb = (w >> (kt & 31)) & 1u; }
        bool doit = true;
        if (MODE == 3) doit = __ballot(selb) != 0ull;
        if (doit) {
            f32x4 Sx[2][4];
#pragma unroll
            for (int tq = 0; tq < 2; ++tq)
#pragma unroll
                for (int st = 0; st < 4; ++st) Sx[tq][st] = (f32x4){0.f, 0.f, 0.f, 0.f};
#pragma unroll
            for (int st = 0; st < 4; ++st)
#pragma unroll
                for (int dc = 0; dc < 4; ++dc) {
                    const bf16x8 kf = *(const bf16x8*)(shm + AL_K + (st * 16 + n) * 272 + dc * 64 + qq * 16);
                    Sx[0][st] = __builtin_amdgcn_mfma_f32_16x16x32_bf16(kf, qf[0][dc], Sx[0][st], 0, 0, 0);
                    Sx[1][st] = __builtin_amdgcn_mfma_f32_16x16x32_bf16(kf, qf[1][dc], Sx[1][st], 0, 0, 0);
                }
#pragma unroll
            for (int st = 0; st < 4; ++st)
#pragma unroll
                for (int r = 0; r < 4; ++r) {
                    const int key = key0 + st * 16 + qq * 4 + r;
                    const int dist = (MODE == 2) ? query - (16 * key + 31) : query - key;
                    bool valid = dist >= 0;
                    if (MODE == 0) valid = valid && dist < 128;
                    if (MODE == 1) valid = valid && dist < 512;
                    if (MODE == 3) valid = valid && selb;
                    int idx = dist < 0 ? 0 : dist; idx = idx > 128 ? 128 : idx;
                    const float b0 = biasL[(2 * hp) * 132 + idx], b1 = biasL[(2 * hp + 1) * 132 + idx];
                    Sx[0][st][r] = valid ? Sx[0][st][r] + b0 : NEG_INF;
                    Sx[1][st][r] = valid ? Sx[1][st][r] + b1 : NEG_INF;
                }
#pragma unroll
            for (int tq = 0; tq < 2; ++tq) {
                if (PASS != 2) {
                    float tm = NEG_INF;
#pragma unroll
                    for (int st = 0; st < 4; ++st)
#pragma unroll
                        for (int r = 0; r < 4; ++r) tm = fmaxf(tm, Sx[tq][st][r]);
                    tm = fmaxf(tm, __shfl_xor(tm, 16)); tm = fmaxf(tm, __shfl_xor(tm, 32));
                    const float mn = fmaxf(m_[tq], tm), mu = (mn == NEG_INF) ? 0.f : mn;
                    const float alpha = __builtin_amdgcn_exp2f(m_[tq] - mu);
                    m_[tq] = mn;
                    float ps = 0.f;
#pragma unroll
                    for (int st = 0; st < 4; ++st)
#pragma unroll
                        for (int r = 0; r < 4; ++r) { const float p = __builtin_amdgcn_exp2f(Sx[tq][st][r] - mu); Sx[tq][st][r] = p; ps += p; }
                    l_[tq] = l_[tq] * alpha + ps;
                    if (PASS == 0) {
#pragma unroll
                        for (int dt = 0; dt < 8; ++dt) O[tq][dt] = O[tq][dt] * alpha;
                    }
                } else {
                    const float mu = (m_[tq] == NEG_INF) ? 0.f : m_[tq];
#pragma unroll
                    for (int st = 0; st < 4; ++st)
#pragma unroll
                        for (int r = 0; r < 4; ++r) Sx[tq][st][r] = __builtin_amdgcn_exp2f(Sx[tq][st][r] - mu) * inv2[tq];
                }
            }
            if (PASS == 2) {
                float a[4], y[4];
#pragma unroll
                for (int st = 0; st < 4; ++st) { a[st] = ((Sx[0][st][0] + Sx[0][st][1]) + (Sx[0][st][2] + Sx[0][st][3])) + ((Sx[1][st][0] + Sx[1][st][1]) + (Sx[1][st][2] + Sx[1][st][3]));
                    y[st] = __shfl(Sx[0][st][3] + Sx[1][st][3], (lane + 48) & 63); }
                float* scL = (float*)(shm + AL_SC) + hp * 128 * 64;
#pragma unroll
                for (int st = 0; st < 4; ++st) { const float extra = (qq > 0) ? y[st] : (st > 0 ? y[st > 0 ? st - 1 : 0] : carry);
                    scL[(16 * kt + 4 * st + qq) * 64 + qs * 16 + n] = a[st] + extra; }
                carry = y[3];
            }
            if (PASS != 1) {
                bf16x8 pb[2][2];
#pragma unroll
                for (int tq = 0; tq < 2; ++tq)
#pragma unroll
                    for (int ch = 0; ch < 2; ++ch) { u32x4 w; w.x = cvt_pk_bf16(Sx[tq][2 * ch][0], Sx[tq][2 * ch][1]); w.y = cvt_pk_bf16(Sx[tq][2 * ch][2], Sx[tq][2 * ch][3]);
                        w.z = cvt_pk_bf16(Sx[tq][2 * ch + 1][0], Sx[tq][2 * ch + 1][1]); w.w = cvt_pk_bf16(Sx[tq][2 * ch + 1][2], Sx[tq][2 * ch + 1][3]); pb[tq][ch] = __builtin_bit_cast(bf16x8, w); }
#pragma unroll
                for (int dt = 0; dt < 8; ++dt)
#pragma unroll
                    for (int ch = 0; ch < 2; ++ch) {
                        const unsigned char* vp = shm + AL_V + (dt * 16 + n) * 144 + (32 * ch + 4 * qq) * 2;
                        const u32x2 lo = *(const u32x2*)vp, hi = *(const u32x2*)(vp + 32);
                        u32x4 vv; vv.x = lo.x; vv.y = lo.y; vv.z = hi.x; vv.w = hi.y;
                        const bf16x8 vf = __builtin_bit_cast(bf16x8, vv);
                        O[0][dt] = __builtin_amdgcn_mfma_f32_16x16x32_bf16(vf, pb[0][ch], O[0][dt], 0, 0, 0);
                        O[1][dt] = __builtin_amdgcn_mfma_f32_16x16x32_bf16(vf, pb[1][ch], O[1][dt], 0, 0, 0);
                    }
            }
        }
    }
}

template <int MODE>
__device__ void attn_item(const Params& P, unsigned char* shm, int qb, int g) {
    unsigned char* ws = P.ws;
    const int tid = threadIdx.x, wid = tid >> 6, lane = tid & 63, n = lane & 15, qq = lane >> 4;
    const int qs = wid >> 1, hp = wid & 1;
    const int s0 = qb * 64, query = s0 + qs * 16 + n;
    const bf16_t* qbuf = (const bf16_t*)(ws + (MODE == 0 ? OFF_QA : OFF_QB));
    const bf16_t* kbase; const bf16_t* vbase; int kstride, vstride;
    if (MODE == 0) { kbase = (const bf16_t*)(ws + OFF_KA) + g * 128; kstride = 512; vbase = (const bf16_t*)(ws + OFF_VA) + (size_t)g * 128 * S_; vstride = S_; }
    else if (MODE == 1) { kbase = (const bf16_t*)(ws + OFF_KW) + g * 128; kstride = 512; vbase = (const bf16_t*)(ws + OFF_VW) + (size_t)g * 128 * S_; vstride = S_; }
    else if (MODE == 3) { kbase = (const bf16_t*)(ws + OFF_KS) + g * 128; kstride = 512; vbase = (const bf16_t*)(ws + OFF_VS) + (size_t)g * 128 * S_; vstride = S_; }
    else { kbase = (const bf16_t*)(ws + OFF_KC) + (size_t)g * 512 * 128; kstride = 128; vbase = (const bf16_t*)(ws + OFF_VCT) + (size_t)g * 128 * 512; vstride = 512; }
    const int hbase = g * 4 + 2 * hp;
    float* biasL = (float*)(shm + AL_BIAS);
    __syncthreads();
    for (int i = tid; i < 4 * 129; i += 512) { const int hh = i / 129, d = i - hh * 129; biasL[hh * 132 + d] = P.rel_bias[(int)T5B[d] * 32 + (MODE == 0 ? 0 : 16) + g * 4 + hh] * LOG2E; }
    bf16x8 qf[2][4];
#pragma unroll
    for (int tq = 0; tq < 2; ++tq)
#pragma unroll
        for (int dc = 0; dc < 4; ++dc) qf[tq][dc] = *(const bf16x8*)(qbuf + (size_t)query * 2048 + (hbase + tq) * 128 + dc * 32 + qq * 8);
    float m_[2], l_[2];
#pragma unroll
    for (int tq = 0; tq < 2; ++tq) { if (MODE == 0) { m_[tq] = P.a_sinks[hbase + tq] * LOG2E; l_[tq] = qq == 0 ? 1.0f : 0.0f; } else { m_[tq] = NEG_INF; l_[tq] = 0.f; } }
    unsigned sm0 = 0, sm1 = 0, sm2 = 0, sm3 = 0;
    if (MODE == 3) { const u32x4 w = *(const u32x4*)((const unsigned*)(ws + OFF_SEL) + ((size_t)g * S_ + query) * 4); sm0 = w.x; sm1 = w.y; sm2 = w.z; sm3 = w.w; }
    int kt_lo, kt_hi;
    if (MODE == 0) { kt_lo = qb - 2 < 0 ? 0 : qb - 2; kt_hi = qb; }
    else if (MODE == 1) { kt_lo = qb - 8 < 0 ? 0 : qb - 8; kt_hi = qb; }
    else if (MODE == 2) { kt_lo = 0; kt_hi = qb >> 4; }
    else { kt_lo = 0; kt_hi = qb; }
    float inv2[2] = {1.f, 1.f};
    f32x4 O[2][8];
    if (MODE == 2) {
        attn_tiles<MODE, 1>(shm, kbase, kstride, vbase, vstride, kt_lo, kt_hi, qf, m_, l_, inv2, O, sm0, sm1, sm2, sm3, query, hp, qs);
#pragma unroll
        for (int tq = 0; tq < 2; ++tq) { float l = l_[tq]; l += __shfl_xor(l, 16); l += __shfl_xor(l, 32); inv2[tq] = l > 0.f ? 1.0f / l : 0.f; }
    }
#pragma unroll
    for (int tq = 0; tq < 2; ++tq)
#pragma unroll
        for (int dt = 0; dt < 8; ++dt) O[tq][dt] = (f32x4){0.f, 0.f, 0.f, 0.f};
    attn_tiles<MODE, (MODE == 2 ? 2 : 0)>(shm, kbase, kstride, vbase, vstride, kt_lo, kt_hi, qf, m_, l_, inv2, O, sm0, sm1, sm2, sm3, query, hp, qs);
    float* obuf = P.out;
#pragma unroll
    for (int tq = 0; tq < 2; ++tq) {
        float sc;
        if (MODE == 2) sc = 1.0f;
        else { float l = l_[tq]; l += __shfl_xor(l, 16); l += __shfl_xor(l, 32); sc = l > 0.f ? 1.0f / l : 0.f; }
        const int h = hbase + tq;
        if (MODE != 0) sc *= ((const float*)(ws + OFF_GATES))[(size_t)query * 48 + h * 3 + (MODE == 1 ? 2 : (MODE == 2 ? 0 : 1))];
        float* op = obuf + (size_t)query * DM + (MODE == 0 ? 0 : 2048) + h * 128 + qq * 4;
#pragma unroll
        for (int dt = 0; dt < 8; ++dt) { f32x4 v = O[tq][dt] * sc; if (MODE >= 2) v = v + *(const f32x4*)(op + dt * 16); *(f32x4*)(op + dt * 16) = v; }
    }
    if (MODE == 2) {
        __syncthreads();
        const float* sc0 = (const float*)(shm + AL_SC); float* fs = (float*)(shm + AL_FS) + wid * 128;
        const int cur = qb, j0 = lane, j1 = lane + 64;
        for (int e = 0; e < 8; ++e) {
            const int ql = wid * 8 + e;
            float v0 = -1.f, v1 = -1.f;
            if (j0 <= cur) { v0 = sc0[j0 * 64 + ql] + sc0[(128 + j0) * 64 + ql]; if (j0 == 0 || j0 == cur || j0 == cur - 1) v0 = 1e6f; }
            if (j1 <= cur) { v1 = sc0[j1 * 64 + ql] + sc0[(128 + j1) * 64 + ql]; if (j1 == cur || j1 == cur - 1) v1 = 1e6f; }
            fs[j0] = v0; fs[j1] = v1;
            __syncthreads();
            int r0 = 0, r1 = 0;
            for (int jj = 0; jj <= cur; ++jj) { const float o = fs[jj]; r0 += (o > v0 || (o == v0 && jj < j0)) ? 1 : 0; r1 += (o > v1 || (o == v1 && jj < j1)) ? 1 : 0; }
            const unsigned long long b0 = __ballot(j0 <= cur && r0 < 16), b1 = __ballot(j1 <= cur && r1 < 16);
            if (lane == 0) { u32x4 w; w.x = (unsigned)b0; w.y = (unsigned)(b0 >> 32); w.z = (unsigned)b1; w.w = (unsigned)(b1 >> 32);
                *(u32x4*)((unsigned*)(ws + OFF_SEL) + ((size_t)g * S_ + s0 + ql) * 4) = w; }
            __syncthreads();
        }
    }
}
template <int MODE>
__device__ __forceinline__ void attn_phase(const Params& P, unsigned char* shm) {
    for (int it = blockIdx.x; it < 512; it += gridDim.x) {
        const int j = it & 255, g = j >> 6; const int qb = it < 256 ? (j & 63) : 127 - (j & 63);
        attn_item<MODE>(P, shm, qb, g);
    }
}

__device__ void phase_outnorm(const Params& P) {
    const int tid = threadIdx.x, wid = tid >> 6, lane = tid & 63;
    bf16_t* on = (bf16_t*)(P.ws + OFF_ON);
    for (int s = blockIdx.x * 8 + wid; s < S_; s += gridDim.x * 8) {
        const f32x4* r = (const f32x4*)(P.out + (size_t)s * DM);
#pragma unroll
        for (int grp = 0; grp < 2; ++grp) {
            f32x4 v[8]; float ss = 0.f;
#pragma unroll
            for (int i = 0; i < 8; ++i) { v[i] = r[grp * 512 + i * 64 + lane]; ss += (v[i][0] * v[i][0] + v[i][1] * v[i][1]) + (v[i][2] * v[i][2] + v[i][3] * v[i][3]); }
            ss = wave_sum(ss); const float rr = rsqrtf(ss * (1.0f / 2048.0f) + EPS_);
#pragma unroll
            for (int i = 0; i < 8; ++i) { u32x2 w; w.x = cvt_pk_bf16(v[i][0] * rr, v[i][1] * rr); w.y = cvt_pk_bf16(v[i][2] * rr, v[i][3] * rr);
                *(u32x2*)(on + (size_t)s * DM + (grp * 512 + i * 64 + lane) * 4) = w; }
        }
    }
}

__device__ void phase_conv(const Params& P) {
    const bf16_t* GU = (const bf16_t*)(P.ws + OFF_GU); bf16_t* hf = (bf16_t*)(P.ws + OFF_HF);
    constexpr int NC = DFF / 8, NITEM = (S_ / 32) * NC;
    for (int it = blockIdx.x * 512 + threadIdx.x; it < NITEM; it += gridDim.x * 512) {
        const int cc = it % NC, rb = it / NC, c0 = cc * 8, r0 = rb * 32;
        float w0[8], w1[8], w2[8], cb[8], g1[8], g2[8];
#pragma unroll
        for (int j = 0; j < 8; ++j) { w0[j] = P.conv_w[c0 + j]; w1[j] = P.conv_w[DFF + c0 + j]; w2[j] = P.conv_w[2 * DFF + c0 + j]; cb[j] = P.conv_b[c0 + j]; g1[j] = 0.f; g2[j] = 0.f; }
        if (r0 > 0) {
            const u32x4 a = *(const u32x4*)(GU + (size_t)(r0 - 2) * NGU + c0), b = *(const u32x4*)(GU + (size_t)(r0 - 1) * NGU + c0);
            g2[0] = bf_lo(a.x); g2[1] = bf_hi(a.x); g2[2] = bf_lo(a.y); g2[3] = bf_hi(a.y); g2[4] = bf_lo(a.z); g2[5] = bf_hi(a.z); g2[6] = bf_lo(a.w); g2[7] = bf_hi(a.w);
            g1[0] = bf_lo(b.x); g1[1] = bf_hi(b.x); g1[2] = bf_lo(b.y); g1[3] = bf_hi(b.y); g1[4] = bf_lo(b.z); g1[5] = bf_hi(b.z); g1[6] = bf_lo(b.w); g1[7] = bf_hi(b.w);
        }
        for (int r = 0; r < 32; ++r) {
            const u32x4 a = *(const u32x4*)(GU + (size_t)(r0 + r) * NGU + c0), ub = *(const u32x4*)(GU + (size_t)(r0 + r) * NGU + DFF + c0);
            float g0[8], u[8], o[8];
            g0[0] = bf_lo(a.x); g0[1] = bf_hi(a.x); g0[2] = bf_lo(a.y); g0[3] = bf_hi(a.y); g0[4] = bf_lo(a.z); g0[5] = bf_hi(a.z); g0[6] = bf_lo(a.w); g0[7] = bf_hi(a.w);
            u[0] = bf_lo(ub.x); u[1] = bf_hi(ub.x); u[2] = bf_lo(ub.y); u[3] = bf_hi(ub.y); u[4] = bf_lo(ub.z); u[5] = bf_hi(ub.z); u[6] = bf_lo(ub.w); u[7] = bf_hi(ub.w);
#pragma unroll
            for (int j = 0; j < 8; ++j) { const float z = cb[j] + w0[j] * g2[j] + w1[j] * g1[j] + w2[j] * g0[j]; o[j] = z / (1.0f + __expf(-z)) * u[j]; g2[j] = g1[j]; g1[j] = g0[j]; }
            u32x4 w; w.x = cvt_pk_bf16(o[0], o[1]); w.y = cvt_pk_bf16(o[2], o[3]); w.z = cvt_pk_bf16(o[4], o[5]); w.w = cvt_pk_bf16(o[6], o[7]);
            *(u32x4*)(hf + (size_t)(r0 + r) * DFF + c0) = w;
        }
    }
}

constexpr int NPHASE = 12;
__global__ void __launch_bounds__(512, 2) hymba_mega(Params P) {
    extern __shared__ __attribute__((aligned(16))) unsigned char shm[];
    cg::grid_group grid = cg::this_grid();
    unsigned char* ws = P.ws;
    if (P.ph_lo <= 0 && 0 < P.ph_hi) { phase_prep(P, shm);
        if (0 + 1 < P.ph_hi) grid.sync(); }
    if (P.ph_lo <= 1 && 1 < P.ph_hi) { { pg8::Gemm g{(const bf16_t*)(ws + OFF_XB), (const bf16_t*)(ws + OFF_WIN), S_, NINP, DM}; pg8::StaticOrder so; so.init(S_, NINP, (int)gridDim.x, (int)blockIdx.x);
            EpiBf16Scale e{(bf16_t*)(ws + OFF_PROJ), NINP, (const float*)(ws + OFF_RSTD0), 0};
            pg8::gemm_phase<EpiBf16Scale, pg8::StaticOrder, false>((PG8_LAS unsigned char*)shm, g, so, e, nullptr); }
        if (1 + 1 < P.ph_hi) grid.sync(); }
    if (P.ph_lo <= 2 && 2 < P.ph_hi) { phase_norm(P, shm);
        if (2 + 1 < P.ph_hi) grid.sync(); }
    if (P.ph_lo <= 3 && 3 < P.ph_hi) { { pg8::Gemm g{(const bf16_t*)(ws + OFF_IM2), (const bf16_t*)(ws + OFF_W1), 4096, 512, 4096}; pg8::StaticOrder so; so.init(4096, 512, (int)gridDim.x, (int)blockIdx.x);
            EpiCmp e{(bf16_t*)(ws + OFF_H), (const float*)(ws + OFF_B1P)};
            pg8::gemm_phase<EpiCmp, pg8::StaticOrder, false>((PG8_LAS unsigned char*)shm, g, so, e, nullptr);
            attn_phase<0>(P, shm); attn_phase<1>(P, shm); }
        if (3 + 1 < P.ph_hi) grid.sync(); }
    if (P.ph_lo <= 4 && 4 < P.ph_hi) { phase_cmp2(P);
        if (4 + 1 < P.ph_hi) grid.sync(); }
    if (P.ph_lo <= 5 && 5 < P.ph_hi) { attn_phase<2>(P, shm);
        if (5 + 1 < P.ph_hi) grid.sync(); }
    if (P.ph_lo <= 6 && 6 < P.ph_hi) { attn_phase<3>(P, shm);
        if (6 + 1 < P.ph_hi) grid.sync(); }
    if (P.ph_lo <= 7 && 7 < P.ph_hi) { phase_outnorm(P);
        if (7 + 1 < P.ph_hi) grid.sync(); }
    if (P.ph_lo <= 8 && 8 < P.ph_hi) { { pg8::Gemm g{(const bf16_t*)(ws + OFF_ON), (const bf16_t*)(ws + OFF_WOUT), S_, DM, DM}; pg8::StaticOrder so; so.init(S_, DM, (int)gridDim.x, (int)blockIdx.x);
            EpiOutProj e{P.x, P.out, (bf16_t*)(ws + OFF_X1B), (float*)(ws + OFF_SS1)};
            pg8::gemm_phase<EpiOutProj, pg8::StaticOrder, false>((PG8_LAS unsigned char*)shm, g, so, e, nullptr); }
        if (8 + 1 < P.ph_hi) grid.sync(); }
    if (P.ph_lo <= 9 && 9 < P.ph_hi) { { pg8::Gemm g{(const bf16_t*)(ws + OFF_X1B), (const bf16_t*)(ws + OFF_WGU), S_, NGU, DM}; pg8::StaticOrder so; so.init(S_, NGU, (int)gridDim.x, (int)blockIdx.x);
            EpiBf16Scale e{(bf16_t*)(ws + OFF_GU), NGU, (const float*)(ws + OFF_SS1), 1};
            pg8::gemm_phase<EpiBf16Scale, pg8::StaticOrder, false>((PG8_LAS unsigned char*)shm, g, so, e, nullptr); }
        if (9 + 1 < P.ph_hi) grid.sync(); }
    if (P.ph_lo <= 10 && 10 < P.ph_hi) { phase_conv(P);
        if (10 + 1 < P.ph_hi) grid.sync(); }
    if (P.ph_lo <= 11 && 11 < P.ph_hi) { { pg8::Gemm g{(const bf16_t*)(ws + OFF_HF), (const bf16_t*)(ws + OFF_WD), S_, DM, DFF}; pg8::StaticOrder so; so.init(S_, DM, (int)gridDim.x, (int)blockIdx.x);
            EpiDown e{P.out};
            pg8::gemm_phase<EpiDown, pg8::StaticOrder, false>((PG8_LAS unsigned char*)shm, g, so, e, nullptr); }
        if (11 + 1 < P.ph_hi) grid.sync(); }
}

extern "C" void kernel_launch(void* const* d_in, const int* in_sizes, int n_in, void* d_out, int out_size, void* d_ws, size_t ws_size, hipStream_t stream) {
    static int grid_blocks = 0;
    if (grid_blocks == 0) {
        if (n_in != 22 || out_size != S_ * DM || ws_size < WS_END) { fprintf(stderr, "kernel_launch: unexpected shapes (n_in %d out %d ws %zu need %zu)\n", n_in, out_size, ws_size, (size_t)WS_END); grid_blocks = -1; return; }
        int dev = 0, cus = 0, per_cu = 0;
        hipGetDevice(&dev); hipDeviceGetAttribute(&cus, hipDeviceAttributeMultiprocessorCount, dev);
        if (hipFuncSetAttribute((const void*)hymba_mega, hipFuncAttributeMaxDynamicSharedMemorySize, LDS_BYTES) != hipSuccess) { fprintf(stderr, "kernel_launch: hipFuncSetAttribute failed\n"); grid_blocks = -1; return; }
        if (hipOccupancyMaxActiveBlocksPerMultiprocessor(&per_cu, (const void*)hymba_mega, 512, LDS_BYTES) != hipSuccess || per_cu < 1) { fprintf(stderr, "kernel_launch: occupancy query failed (%d)\n", per_cu); (void)hipGetLastError(); per_cu = 1; }
        grid_blocks = cus * per_cu;
    }
    if (grid_blocks < 0) return;
    Params P{};
    const float** pp = (const float**)&P;
    for (int i = 0; i < 22; ++i) pp[i] = (const float*)d_in[i];
    P.out = (float*)d_out; P.ws = (unsigned char*)d_ws; P.ph_lo = 0; P.ph_hi = NPHASE;
    void* args[] = {&P};
    hipError_t e = hipLaunchCooperativeKernel((const void*)hymba_mega, dim3(grid_blocks), dim3(512), args, LDS_BYTES, stream);
    if (e != hipSuccess) fprintf(stderr, "cooperative launch failed: %s (grid %d)\n", hipGetErrorString(e), grid_blocks);
}
```

```cpp
#include <hip/hip_runtime.h>
#include <hip/hip_cooperative_groups.h>
#include <cstdio>
#include <cstdint>
namespace cg = cooperative_groups;
#include <type_traits>
namespace pg8 {
#define PG8_LAS __attribute__((address_space(3)))
typedef unsigned short bf16_t;
typedef short bf16x8 __attribute__((ext_vector_type(8)));
typedef float f32x4 __attribute__((ext_vector_type(4)));
typedef unsigned u32x4 __attribute__((ext_vector_type(4)));
constexpr int BM = 256, BK = 64, HALF = 128, HTB = HALF * BK * 2  , STAGE_BYTES = 8 * HTB, NXCD = 8, WGM = 8;

__host__ __device__ __forceinline__ int lds_byte(int r, int c) { const int st = (r >> 4) * 2 + (c >> 5), rr = r & 15, cc = c & 31, ob = rr * 64 + cc * 2; return st * 1024 + (ob ^ (((ob >> 9) & 1) << 5)); }
__host__ __device__ __forceinline__ void stage_rc(int b, int& R, int& C) { const int st = b / 1024, sb = b % 1024, swz = sb ^ (((sb >> 9) & 1) << 5); R = (st >> 1) * 16 + swz / 64; C = (st & 1) * 32 + (swz % 64) / 2; }
__host__ __device__ __forceinline__ int perm32(int rho) { const int n = rho >> 4, i = rho & 15; return 8 * (i >> 2) + 4 * n + (i & 3); }

struct Unit { int pm, pn; };
struct Gemm { const bf16_t* A; const bf16_t* Bt; int M, N, K, ld; };

struct StaticOrder {
    int nM, nN, nwg, G, c;
    __host__ __device__ void init(int M, int N, int G_, int c_) { nM = M / BM; nN = N / BM; nwg = nM * nN; G = G_; c = c_; }
    __host__ __device__ bool next(int i, Unit& u) const {
        const long L = (long)i * G + c; if (L >= nwg) return false;
        int wgid = (int)L; { const int q = nwg / NXCD, r = nwg % NXCD, xcd = wgid % NXCD, off = wgid / NXCD; wgid = (xcd < r ? xcd * (q + 1) : r * (q + 1) + (xcd - r) * q) + off; }
        const int nig = WGM * nN, gid = wgid / nig, fm = gid * WGM, gsz = (nM - fm) < WGM ? (nM - fm) : WGM;
        u.pm = fm + ((wgid % nig) % gsz); u.pn = (wgid % nig) / gsz; return true;
    }
    __device__ __forceinline__ void a_ready(const Unit&) const {}
    __device__ __forceinline__ void done(const Unit&) const {}
};
__device__ __forceinline__ unsigned cvt_pk_bf16(float lo, float hi) { unsigned r; asm volatile("v_cvt_pk_bf16_f32 %0, %1, %2" : "=v"(r) : "v"(lo), "v"(hi)); return r; }
template <class Epi, class Sched, bool STAMP = false>
__device__ __forceinline__ void gemm_phase(PG8_LAS unsigned char* lds, const Gemm g, const Sched& S, const Epi& E, unsigned long long* stamps) {
    const int tid = threadIdx.x, wid = __builtin_amdgcn_readfirstlane(tid >> 6), lane = tid & 63, wr = wid >> 2, wc = wid & 3, fr = lane & 15, fq = lane >> 4;
    const int K = g.ld, nt = g.K / BK;
    int ts_lo = 0, ts_hi = 0, nts = 0; const unsigned long long rt_entry = STAMP ? (unsigned long long)wall_clock64() : 0ull;
#define PG8_STAMP() do { if (STAMP && wid == 0 && nts < 64) { const unsigned long long _c = (unsigned long long)clock64(); \
        ts_lo = (lane == nts) ? (int)(unsigned)_c : ts_lo; ts_hi = (lane == nts) ? (int)(unsigned)(_c >> 32) : ts_hi; ++nts; } } while (0)
    PG8_STAMP();
    unsigned voffA[2], voffB[2];
#pragma unroll
    for (int i = 0; i < 2; ++i) { int R, C; stage_rc(tid * 16 + i * 8192, R, C); const int Rb = Epi::PERM ? ((R & ~31) + perm32(R & 31)) : R;
        voffA[i] = (unsigned)(R * K + C) * 2u; voffB[i] = (unsigned)(Rb * K + C) * 2u; }
    const size_t kstep = (size_t)(BK * 2);
    const size_t hstep = (size_t)HALF * K * 2;
    const size_t tstep = 2 * hstep;
    const unsigned ldsw = (unsigned)wid * 1024u;
    const int aoff = lds_byte(wr * 64 + fr, fq * 8), boff = lds_byte(wc * 32 + fr, fq * 8);
#define PG8_SA(b, h) (((b) * 2 + (h)) * HTB)
#define PG8_SB(b, h) ((4 + (b) * 2 + (h)) * HTB)
#define PG8_STAGE(bufoff, gbase, voff) do { _Pragma("unroll") for (int _i = 0; _i < 2; ++_i) \
        __builtin_amdgcn_global_load_lds((const unsigned*)((const char*)(gbase) + (voff)[_i]), (PG8_LAS unsigned*)(lds + (bufoff) + ldsw + _i * 8192), 16, 0, 0); } while (0)
#define PG8_LDA(dst, b, h) do { _Pragma("unroll") for (int m = 0; m < 4; ++m) _Pragma("unroll") for (int k = 0; k < 2; ++k) dst[m][k] = *(const PG8_LAS bf16x8*)(lds + PG8_SA(b, h) + aoff + m * 2048 + k * 1024); } while (0)
#define PG8_LDB(dst, b, h) do { _Pragma("unroll") for (int n = 0; n < 2; ++n) _Pragma("unroll") for (int k = 0; k < 2; ++k) dst[n][k] = *(const PG8_LAS bf16x8*)(lds + PG8_SB(b, h) + boff + n * 2048 + k * 1024); } while (0)
#define PG8_MMA(ai, bj, At, Bt) do { __builtin_amdgcn_s_setprio(1); _Pragma("unroll") for (int m = 0; m < 4; ++m) _Pragma("unroll") for (int n = 0; n < 2; ++n) _Pragma("unroll") for (int k = 0; k < 2; ++k) \
        acc[ai][bj][m][n] = __builtin_amdgcn_mfma_f32_16x16x32_bf16(Bt[n][k], At[m][k], acc[ai][bj][m][n], 0, 0, 0); __builtin_amdgcn_s_setprio(0); } while (0)
#define PG8_WAIT_V(n) asm volatile("s_waitcnt vmcnt(" #n ")" ::: "memory")
#define PG8_WAIT_L(n) asm volatile("s_waitcnt lgkmcnt(" #n ")" ::: "memory")
#define PG8_BAR __builtin_amdgcn_s_barrier()
#define PG8_SCHED __builtin_amdgcn_sched_barrier(0)
    Unit cur, nxt; int ui = 0;
    if (!S.next(0, cur)) return;
    f32x4 acc[2][2][4][2];
#pragma unroll
    for (int a = 0; a < 2; ++a)
#pragma unroll
        for (int b = 0; b < 2; ++b)
#pragma unroll
            for (int m = 0; m < 4; ++m)
#pragma unroll
                for (int n = 0; n < 2; ++n) acc[a][b][m][n] = (f32x4){0.f, 0.f, 0.f, 0.f};
    bf16x8 At[4][2], B0[2][2], B1[2][2];
    const char* cA = (const char*)g.A + (size_t)cur.pm * tstep; const char* cB = (const char*)g.Bt + (size_t)cur.pn * tstep;
    S.a_ready(cur);
    PG8_STAGE(PG8_SB(0, 0), cB, voffB); PG8_STAGE(PG8_SA(0, 0), cA, voffA); PG8_STAGE(PG8_SB(0, 1), cB + hstep, voffB); PG8_STAGE(PG8_SA(0, 1), cA + hstep, voffA);
    if (wr == 1) PG8_BAR;
    PG8_WAIT_V(4); PG8_BAR;
    PG8_STAGE(PG8_SB(1, 0), cB + kstep, voffB); PG8_STAGE(PG8_SA(1, 0), cA + kstep, voffA); PG8_STAGE(PG8_SB(1, 1), cB + hstep + kstep, voffB);
    PG8_WAIT_V(6); PG8_BAR;
    PG8_STAMP();
    for (;;) {
        const bool has_next = S.next(ui + 1, nxt);
        const char* nA = has_next ? (const char*)g.A + (size_t)nxt.pm * tstep : cA; const char* nB = has_next ? (const char*)g.Bt + (size_t)nxt.pn * tstep : cB;
        for (int t = 0; t < nt; t += 2) {
            const bool last = (t == nt - 2);
            if constexpr (Epi::MIDSCALE) { if (t == (nt >> 1)) E.mid(acc, cur, wr, wc, fr, fq); }
            const char* a1 = cA + (size_t)(t + 1) * kstep;
            const char* a2 = last ? nA : cA + (size_t)(t + 2) * kstep; const char* b2 = last ? nB : cB + (size_t)(t + 2) * kstep;
            const char* a3 = a2 + kstep; const char* b3 = b2 + kstep;
            if (last && has_next) S.a_ready(nxt);
            PG8_LDB(B0, 0, 0); PG8_SCHED; PG8_LDA(At, 0, 0); PG8_STAGE(PG8_SA(1, 1), a1 + hstep, voffA);
            PG8_WAIT_L(8); PG8_BAR; PG8_WAIT_L(0); PG8_MMA(0, 0, At, B0); PG8_BAR; PG8_SCHED;
            PG8_LDB(B1, 0, 1); PG8_STAGE(PG8_SB(0, 0), b2, voffB);
            PG8_BAR; PG8_WAIT_L(0); PG8_MMA(0, 1, At, B1); PG8_BAR;
            PG8_LDA(At, 0, 1); PG8_STAGE(PG8_SA(0, 0), a2, voffA);
            PG8_BAR; PG8_WAIT_L(0); PG8_MMA(1, 0, At, B0); PG8_BAR; PG8_SCHED;
            PG8_STAGE(PG8_SB(0, 1), b2 + hstep, voffB);
            PG8_WAIT_V(6); PG8_BAR; PG8_MMA(1, 1, At, B1); PG8_BAR;
            PG8_LDB(B0, 1, 0); PG8_SCHED; PG8_LDA(At, 1, 0); PG8_STAGE(PG8_SA(0, 1), a2 + hstep, voffA);
            PG8_WAIT_L(8); PG8_BAR; PG8_WAIT_L(0); PG8_MMA(0, 0, At, B0); PG8_BAR; PG8_SCHED;
            PG8_LDB(B1, 1, 1); PG8_STAGE(PG8_SB(1, 0), b3, voffB);
            PG8_BAR; PG8_WAIT_L(0); PG8_MMA(0, 1, At, B1); PG8_BAR;
            PG8_LDA(At, 1, 1); PG8_STAGE(PG8_SA(1, 0), a3, voffA);
            PG8_BAR; PG8_WAIT_L(0); PG8_MMA(1, 0, At, B0); PG8_BAR; PG8_SCHED;
            PG8_STAGE(PG8_SB(1, 1), b3 + hstep, voffB);
            PG8_WAIT_V(6); PG8_BAR; PG8_MMA(1, 1, At, B1); PG8_BAR;
        }
        PG8_STAMP();
        if constexpr (!Epi::AFTER_DRAIN) { E(acc, cur, wr, wc, fr, fq); S.done(cur); }
        PG8_STAMP();
        if (!has_next) break;
#pragma unroll
        for (int a = 0; a < 2; ++a)
#pragma unroll
            for (int b = 0; b < 2; ++b)
#pragma unroll
                for (int m = 0; m < 4; ++m)
#pragma unroll
                    for (int n = 0; n < 2; ++n) acc[a][b][m][n] = (f32x4){0.f, 0.f, 0.f, 0.f};
        cur = nxt; cA = nA; cB = nB; ++ui;
    }
    PG8_WAIT_V(0);
    if (wr == 0) PG8_BAR;
    PG8_BAR;
    if constexpr (Epi::AFTER_DRAIN) { E.fused(acc, cur, wr, wc, fr, fq, lds, wid, lane); S.done(cur); }
    PG8_STAMP();
    if (STAMP && wid == 0) { stamps[lane] = lane < nts ? (((unsigned long long)(unsigned)ts_hi << 32) | (unsigned)ts_lo) : 0ull;
        if (lane == 62) stamps[62] = rt_entry; if (lane == 63) stamps[63] = (unsigned long long)wall_clock64(); }
#undef PG8_STAMP
#undef PG8_SA
#undef PG8_SB
#undef PG8_STAGE
#undef PG8_LDA
#undef PG8_LDB
#undef PG8_MMA
#undef PG8_WAIT_V
#undef PG8_WAIT_L
#undef PG8_BAR
#undef PG8_SCHED
}
}

#define LAS __attribute__((address_space(3)))
typedef unsigned short bf16_t;
typedef short bf16x8 __attribute__((ext_vector_type(8)));
typedef float f32x4 __attribute__((ext_vector_type(4)));
typedef unsigned u32x4 __attribute__((ext_vector_type(4)));
typedef unsigned u32x2 __attribute__((ext_vector_type(2)));
using pg8::cvt_pk_bf16;

constexpr int S_ = 8192, DM = 4096, NIN = 8240, NINP = 8448, DFF = 11008, NGU = 22016;
constexpr float EPS_ = 1e-6f;
constexpr float LOG2E = 1.4426950408889634f;
constexpr float QSCALE = 0.08838834764831845f * 1.4426950408889634f;
constexpr int LDS_STAGE = 147456, LDS_BYTES = LDS_STAGE + 256;

constexpr size_t SZ_WGU = (size_t)NGU * DM * 2, SZ_WD = (size_t)DM * DFF * 2, SZ_WOUT = (size_t)DM * DM * 2, SZ_W1 = 512ull * 4096 * 2, SZ_SMALL = 1u << 20;
constexpr size_t OFF_WGU = 0, OFF_WD = OFF_WGU + SZ_WGU, OFF_WOUT = OFF_WD + SZ_WD, OFF_W1 = OFF_WOUT + SZ_WOUT, OFF_SMALL = OFF_W1 + SZ_W1;
constexpr size_t OFF_BAR = OFF_SMALL + 262144;
constexpr size_t OFF_SSAB = OFF_SMALL + 327680;
constexpr size_t OFF_MREF = OFF_SMALL + 197632;
constexpr size_t OFF_QCTR = OFF_SMALL + 196608;
constexpr size_t OFF_RSTD0 = OFF_SMALL, OFF_SS1 = OFF_SMALL + 32768, OFF_B1PART = OFF_SMALL + 65536, OFF_B1P = OFF_SMALL + 131072;
constexpr size_t OFF_C = OFF_SMALL + SZ_SMALL;
constexpr size_t SZ_Q = (size_t)S_ * 2048 * 2, SZ_KV = (size_t)S_ * 512 * 2;
constexpr size_t OFF_QA = OFF_C, OFF_QB = OFF_QA + SZ_Q, OFF_KA = OFF_QB + SZ_Q, OFF_KS = OFF_KA + SZ_KV, OFF_KW = OFF_KS + SZ_KV;
constexpr size_t OFF_VA = OFF_KW + SZ_KV, OFF_VS = OFF_VA + SZ_KV, OFF_VW = OFF_VS + SZ_KV;
constexpr size_t OFF_GATES = OFF_VW + SZ_KV, SZ_GATES = (size_t)S_ * 48 * 4;
constexpr size_t OFF_IM2 = OFF_GATES + SZ_GATES, SZ_IM2 = 4096ull * 4096 * 2;
constexpr size_t OFF_H = OFF_IM2 + SZ_IM2, SZ_H = 4096ull * 256 * 2;
constexpr size_t OFF_KC = OFF_H + SZ_H, SZ_KC = 4ull * 512 * 128 * 2;
constexpr size_t OFF_VCT = OFF_KC + SZ_KC;
constexpr size_t OFF_SEL = OFF_VCT + SZ_KC, SZ_SEL = 4ull * S_ * 16;
constexpr size_t OFF_B = OFF_SEL + SZ_SEL;
constexpr size_t SZ_WIN = (size_t)NINP * DM * 2, SZ_XB = (size_t)S_ * DM * 2, SZ_PROJ = (size_t)S_ * NINP * 2;
constexpr size_t OFF_WIN = OFF_B, OFF_XB = OFF_WIN + SZ_WIN, OFF_PROJ = OFF_XB + SZ_XB;
constexpr size_t OFF_HACC = OFF_PROJ + SZ_PROJ, SZ_HACC = 4096ull * 256 * 4;
constexpr size_t OFF_GACC = OFF_HACC + SZ_HACC, SZ_GACC = (size_t)S_ * 48 * 4;
constexpr size_t WS_END = OFF_GACC + SZ_GACC;
constexpr size_t OFF_GU = OFF_C, SZ_GU = (size_t)S_ * NGU * 2;
constexpr size_t OFF_X1B = OFF_PROJ + SZ_PROJ - SZ_XB;
constexpr size_t OFF_ON = OFF_WIN;
constexpr size_t SZ_STASH = 32ull * 2 * DFF * 4;
constexpr size_t OFF_STL = OFF_C, OFF_STG = OFF_STL + SZ_STASH, OFF_STU = OFF_STG + SZ_STASH;
constexpr size_t OFF_HF = OFF_C + (16u << 20);
static_assert(OFF_STU + SZ_STASH <= OFF_HF && OFF_HF + (size_t)S_ * DFF * 2 <= OFF_X1B, "h / stash placement");
static_assert(OFF_X1B >= OFF_GU + SZ_GU, "x1b overlaps GU");
static_assert(SZ_XB <= SZ_WIN, "o_n overlay");

struct Params {
    const float *x, *rel_bias, *norm_mix_g, *w_in, *a_q_g, *a_k_g, *a_sinks, *b_q_g, *b_k_g, *pos_emb, *cmp_w1, *cmp_b1, *cmp_w2, *cmp_b2,
        *out_norm_g, *w_out, *norm_ffn_g, *w_gate, *w_up, *conv_w, *conv_b, *w_down;
    float* out;
    unsigned char* ws;
    int ph_lo, ph_hi, one, pad_;
};

__device__ __forceinline__ float bf_lo(unsigned w) { return __uint_as_float(w << 16); }
__device__ __forceinline__ float bf_hi(unsigned w) { return __uint_as_float(w & 0xffff0000u); }
__device__ __forceinline__ float wave_sum(float v) {
#pragma unroll
    for (int o = 32; o >= 1; o >>= 1) v += __shfl_xor(v, o);
    return v;
}
__constant__ unsigned char T5B[132] = {0, 1, 2, 3, 4, 5, 6, 7, 8, 9, 10, 11, 12, 13, 14, 15, 16, 16, 16, 17, 17, 18, 18, 18, 19, 19, 19, 20, 20, 20, 20, 21, 21, 21, 21, 22, 22, 22, 22, 22, 23, 23, 23, 23, 23, 23, 24, 24, 24, 24, 24, 24, 25, 25, 25, 25, 25, 25, 25, 26, 26, 26, 26, 26, 26, 26, 26, 27, 27, 27, 27, 27, 27, 27, 27, 27, 27, 28, 28, 28, 28, 28, 28, 28, 28, 28, 28, 29, 29, 29, 29, 29, 29, 29, 29, 29, 29, 29, 29, 30, 30, 30, 30, 30, 30, 30, 30, 30, 30, 30, 30, 30, 30, 31, 31, 31, 31, 31, 31, 31, 31, 31, 31, 31, 31, 31, 31, 31, 31, 31, 31, 31};

struct EpiBf16Scale {
    static constexpr bool PERM = true, AFTER_DRAIN = false, MIDSCALE = false;
    bf16_t* O; int ldc; const float* rs; int mode;
    __device__ __forceinline__ void operator()(const f32x4 (&acc)[2][2][4][2], const pg8::Unit& u, int wr, int wc, int fr, int fq) const {
        const int row0 = u.pm * 256 + wr * 64 + fr, col0 = u.pn * 256 + wc * 32 + 8 * fq;
#pragma unroll
        for (int ai = 0; ai < 2; ++ai)
#pragma unroll
            for (int m = 0; m < 4; ++m) {
                const int row = row0 + ai * 128 + m * 16;
                float sc = rs[row]; if (mode) sc = rsqrtf(sc * (1.0f / 4096.0f) + EPS_);
                bf16_t* rowp = O + (size_t)row * ldc + col0;
#pragma unroll
                for (int bj = 0; bj < 2; ++bj) { const f32x4 v0 = acc[ai][bj][m][0] * sc, v1 = acc[ai][bj][m][1] * sc;
                    u32x4 w; w.x = cvt_pk_bf16(v0[0], v0[1]); w.y = cvt_pk_bf16(v0[2], v0[3]); w.z = cvt_pk_bf16(v1[0], v1[1]); w.w = cvt_pk_bf16(v1[2], v1[3]);
                    *(u32x4*)(rowp + bj * 128) = w; }
            }
    }
};
struct EpiCmp {
    static constexpr bool PERM = false, AFTER_DRAIN = false, MIDSCALE = false;
    float* Hacc;
    __device__ __forceinline__ void operator()(const f32x4 (&acc)[2][2][4][2], const pg8::Unit& u, int wr, int wc, int fr, int fq) const {
        if ((u.pm >> 3) != u.pn) return;
        const int row0 = u.pm * 256 + wr * 64 + fr, col0 = wc * 32 + 4 * fq;
#pragma unroll
        for (int ai = 0; ai < 2; ++ai)
#pragma unroll
            for (int m = 0; m < 4; ++m) { float* rp = Hacc + (size_t)(row0 + ai * 128 + m * 16) * 256 + col0;
#pragma unroll
                for (int bj = 0; bj < 2; ++bj)
#pragma unroll
                    for (int n = 0; n < 2; ++n)
#pragma unroll
                        for (int j = 0; j < 4; ++j) atomicAdd(rp + bj * 128 + n * 16 + j, acc[ai][bj][m][n][j]); }
    }
};
struct EpiGates {
    static constexpr bool PERM = false, AFTER_DRAIN = false, MIDSCALE = false;
    float* gacc; const float* rstd;
    __device__ __forceinline__ void operator()(const f32x4 (&acc)[2][2][4][2], const pg8::Unit& u, int wr, int wc, int fr, int fq) const {
        if (wc > 1) return;
        const int row0 = u.pm * 256 + wr * 64 + fr;
#pragma unroll
        for (int ai = 0; ai < 2; ++ai)
#pragma unroll
            for (int m = 0; m < 4; ++m) {
                const int row = row0 + ai * 128 + m * 16; const float sc = rstd[row];
#pragma unroll
                for (int n = 0; n < 2; ++n) { const int col = wc * 32 + n * 16 + 4 * fq;
                    if (col < 48) {
#pragma unroll
                        for (int j = 0; j < 4; ++j) atomicAdd(gacc + (size_t)row * 48 + col + j, acc[ai][0][m][n][j] * sc); } }
            }
    }
};
struct EpiGateUp {
    static constexpr bool PERM = true, AFTER_DRAIN = false, MIDSCALE = false;
    bf16_t* hf; const float* ss1; const float* conv_w; const float* conv_b; float* stL; float* stG; float* stU; LAS float* X;
    __device__ __forceinline__ void operator()(const f32x4 (&acc)[2][2][4][2], const pg8::Unit& u, int wr, int wc, int fr, int fq) const {
        const int rowb = u.pm * 256 + wr * 64 + fr, colL = wc * 32 + 8 * fq, colG = u.pn * 128 + colL;
        float sc[2][4];
#pragma unroll
        for (int ai = 0; ai < 2; ++ai)
#pragma unroll
            for (int m = 0; m < 4; ++m) sc[ai][m] = rsqrtf(ss1[rowb + ai * 128 + m * 16] * (1.0f / 4096.0f) + EPS_);
        if (fr >= 14) {
#pragma unroll
            for (int ai = 0; ai < 2; ++ai)
#pragma unroll
                for (int n = 0; n < 2; ++n) { const f32x4 g = acc[ai][0][3][n] * sc[ai][3];
                    *(LAS f32x4*)(X + (((ai * 2 + wr) * 2 + (fr - 14)) * 128) + colL + 4 * n) = g;
                    if (ai == 1 && wr == 1) *(f32x4*)(stL + ((size_t)u.pm * 2 + (fr - 14)) * DFF + colG + 4 * n) = g; }
        }
        if (fr < 2 && wr == 0) {
#pragma unroll
            for (int n = 0; n < 2; ++n) { *(f32x4*)(stG + ((size_t)u.pm * 2 + fr) * DFF + colG + 4 * n) = acc[0][0][0][n] * sc[0][0];
                                          *(f32x4*)(stU + ((size_t)u.pm * 2 + fr) * DFF + colG + 4 * n) = acc[0][1][0][n] * sc[0][0]; }
        }
        f32x4 cw0[2], cw1[2], cw2[2], ccb[2];
#pragma unroll
        for (int n = 0; n < 2; ++n) { cw0[n] = *(const f32x4*)(conv_w + colG + 4 * n); cw1[n] = *(const f32x4*)(conv_w + DFF + colG + 4 * n); cw2[n] = *(const f32x4*)(conv_w + 2 * DFF + colG + 4 * n); ccb[n] = *(const f32x4*)(conv_b + colG + 4 * n); }
        asm volatile("s_waitcnt lgkmcnt(0)" ::: "memory"); __builtin_amdgcn_s_barrier(); __builtin_amdgcn_s_barrier(); asm volatile("" ::: "memory");
#pragma unroll
        for (int ai = 0; ai < 2; ++ai) {
            const bool havepred = (wr == 1) || (ai == 1);
            const int pblk = (wr == 1) ? ai * 2 : 1;
            u32x2 hp[4][2];
#pragma unroll
            for (int n = 0; n < 2; ++n) {
                const f32x4 w0 = cw0[n], w1 = cw1[n], w2 = cw2[n], cb = ccb[n];
                f32x4 B62 = {0.f, 0.f, 0.f, 0.f}, B63 = {0.f, 0.f, 0.f, 0.f};
                if (havepred) { B62 = *(const LAS f32x4*)(X + (pblk * 2 + 0) * 128 + colL + 4 * n); B63 = *(const LAS f32x4*)(X + (pblk * 2 + 1) * 128 + colL + 4 * n); }
                f32x4 g[4], s1[4], s2[4];
#pragma unroll
                for (int m = 0; m < 4; ++m) g[m] = acc[ai][0][m][n] * sc[ai][m];
#pragma unroll
                for (int m = 0; m < 4; ++m)
#pragma unroll
                    for (int j = 0; j < 4; ++j) { const int gi = __float_as_int(g[m][j]); s1[m][j] = __int_as_float(__builtin_amdgcn_mov_dpp(gi, 0x121, 0xf, 0xf, false)); s2[m][j] = __int_as_float(__builtin_amdgcn_mov_dpp(gi, 0x122, 0xf, 0xf, false)); }
#pragma unroll
                for (int m = 0; m < 4; ++m) {
                    const f32x4 p1 = (fr >= 1) ? s1[m] : (m > 0 ? s1[m > 0 ? m - 1 : 0] : B63);
                    const f32x4 p2 = (fr >= 2) ? s2[m] : (m > 0 ? s2[m > 0 ? m - 1 : 0] : (fr == 1 ? B63 : B62));
                    const f32x4 uu = acc[ai][1][m][n] * sc[ai][m];
                    const f32x4 z = cb + w0 * p2 + w1 * p1 + w2 * g[m];
                    f32x4 hv;
#pragma unroll
                    for (int j = 0; j < 4; ++j) hv[j] = z[j] * __builtin_amdgcn_rcpf(1.0f + __expf(-z[j])) * uu[j];
                    hp[m][n].x = cvt_pk_bf16(hv[0], hv[1]); hp[m][n].y = cvt_pk_bf16(hv[2], hv[3]);
                }
            }
#pragma unroll
            for (int m = 0; m < 4; ++m) {
                const bool skip = (ai == 0) && (wr == 0) && (m == 0) && (fr < 2);
                if (!skip) { u32x4 w; w.x = hp[m][0].x; w.y = hp[m][0].y; w.z = hp[m][1].x; w.w = hp[m][1].y;
                    *(u32x4*)(hf + (size_t)(rowb + ai * 128 + m * 16) * DFF + colG) = w; }
            }
        }
    }
};
struct EpiOutProj {
    static constexpr bool PERM = false, AFTER_DRAIN = false, MIDSCALE = true;
    const float* x; float* out; bf16_t* x1b; float* ss1; int dry; const float* ssAB;
    __device__ __forceinline__ void mid(f32x4 (&acc)[2][2][4][2], const pg8::Unit& u, int wr, int wc, int fr, int fq) const {
        const int row0 = u.pm * 256 + wr * 64 + fr;
#pragma unroll
        for (int ai = 0; ai < 2; ++ai) {
            float2 s[4];
#pragma unroll
            for (int m = 0; m < 4; ++m) s[m] = *(const float2*)(ssAB + 2 * (row0 + ai * 128 + m * 16));
#pragma unroll
            for (int m = 0; m < 4; ++m) {
                const float r = rsqrtf(s[m].x * (1.0f / 2048.0f) + EPS_) * sqrtf(s[m].y * (1.0f / 2048.0f) + EPS_);
#pragma unroll
                for (int bj = 0; bj < 2; ++bj)
#pragma unroll
                    for (int n = 0; n < 2; ++n) acc[ai][bj][m][n] = acc[ai][bj][m][n] * r; }
            asm volatile("" ::: "memory");
        }
    }
    __device__ __forceinline__ void operator()(const f32x4 (&acc)[2][2][4][2], const pg8::Unit& u, int wr, int wc, int fr, int fq) const {
        if (dry) return;
        const int row0 = u.pm * 256 + wr * 64 + fr, col0 = u.pn * 256 + wc * 32 + 4 * fq;
#pragma unroll
        for (int ai = 0; ai < 2; ++ai)
#pragma unroll
            for (int mp = 0; mp < 4; mp += 2) {
                f32x4 xv[2][2][2]; float rB[2];
#pragma unroll
                for (int mm = 0; mm < 2; ++mm) { const int row = row0 + ai * 128 + (mp + mm) * 16; const size_t off = (size_t)row * DM + col0;
                    rB[mm] = ssAB[2 * row + 1];
#pragma unroll
                    for (int bj = 0; bj < 2; ++bj)
#pragma unroll
                        for (int n = 0; n < 2; ++n) xv[mm][bj][n] = *(const f32x4*)(x + off + bj * 128 + n * 16); }
#pragma unroll
                for (int mm = 0; mm < 2; ++mm) { const int m = mp + mm; const int row = row0 + ai * 128 + m * 16; const size_t off = (size_t)row * DM + col0; float ss = 0.f;
                    const float rb = rsqrtf(rB[mm] * (1.0f / 2048.0f) + EPS_);
#pragma unroll
                    for (int bj = 0; bj < 2; ++bj)
#pragma unroll
                        for (int n = 0; n < 2; ++n) { const f32x4 o = xv[mm][bj][n] + acc[ai][bj][m][n] * rb;
                            *(f32x4*)(out + off + bj * 128 + n * 16) = o;
                            u32x2 w; w.x = cvt_pk_bf16(o[0], o[1]); w.y = cvt_pk_bf16(o[2], o[3]); *(u32x2*)(x1b + off + bj * 128 + n * 16) = w;
                            ss += (o[0] * o[0] + o[1] * o[1]) + (o[2] * o[2] + o[3] * o[3]); }
                    ss += __shfl_xor(ss, 16); ss += __shfl_xor(ss, 32);
                    if (fq == 0) atomicAdd(ss1 + row, ss); }
            }
    }
};
struct EpiDown {
    static constexpr bool PERM = false, AFTER_DRAIN = false, MIDSCALE = false;
    float* out; int dry;
    __device__ __forceinline__ void operator()(const f32x4 (&acc)[2][2][4][2], const pg8::Unit& u, int wr, int wc, int fr, int fq) const {
        if (dry) return;
        const int row0 = u.pm * 256 + wr * 64 + fr, col0 = u.pn * 256 + wc * 32 + 4 * fq;
#pragma unroll
        for (int ai = 0; ai < 2; ++ai)
#pragma unroll
            for (int mp = 0; mp < 4; mp += 2) {
                f32x4 ov[2][2][2];
#pragma unroll
                for (int mm = 0; mm < 2; ++mm)
#pragma unroll
                    for (int bj = 0; bj < 2; ++bj)
#pragma unroll
                        for (int n = 0; n < 2; ++n) ov[mm][bj][n] = *(const f32x4*)(out + (size_t)(row0 + ai * 128 + (mp + mm) * 16) * DM + col0 + bj * 128 + n * 16);
#pragma unroll
                for (int mm = 0; mm < 2; ++mm)
#pragma unroll
                    for (int bj = 0; bj < 2; ++bj)
#pragma unroll
                        for (int n = 0; n < 2; ++n) *(f32x4*)(out + (size_t)(row0 + ai * 128 + (mp + mm) * 16) * DM + col0 + bj * 128 + n * 16) = ov[mm][bj][n] + acc[ai][bj][mp + mm][n];
            }
    }
};

struct TDesc { const float* src; const float* gain; bf16_t* dst; int K, N, kt, nt, drow0; };
struct TRegs { f32x4 a[2], b[2]; float ga[2], gb[2]; };
__device__ __forceinline__ void tconv_load(const TDesc& t, TRegs& r) {
    const int tid = threadIdx.x, n4 = (tid & 31) * 4, kp = tid >> 5, k0 = t.kt * 64, n0 = t.nt * 128;
#pragma unroll
    for (int i = 0; i < 2; ++i) {
        const int kk = 2 * (kp + 16 * i);
        r.a[i] = (f32x4){0.f, 0.f, 0.f, 0.f}; r.b[i] = (f32x4){0.f, 0.f, 0.f, 0.f};
        if (n0 + n4 < t.N) { r.a[i] = __builtin_nontemporal_load((const f32x4*)(t.src + (size_t)(k0 + kk) * t.N + n0 + n4)); r.b[i] = __builtin_nontemporal_load((const f32x4*)(t.src + (size_t)(k0 + kk + 1) * t.N + n0 + n4)); }
        r.ga[i] = t.gain ? t.gain[k0 + kk] : 1.0f; r.gb[i] = t.gain ? t.gain[k0 + kk + 1] : 1.0f;
    }
}
__device__ __forceinline__ void tconv_store(unsigned* ldsw, const TDesc& t, const TRegs& r) {
    const int tid = threadIdx.x, n4 = (tid & 31) * 4, kp = tid >> 5, k0 = t.kt * 64, n0 = t.nt * 128;
#pragma unroll
    for (int i = 0; i < 2; ++i) {
        const f32x4 a = r.a[i] * r.ga[i], b = r.b[i] * r.gb[i];
#pragma unroll
        for (int j = 0; j < 4; ++j) ldsw[(n4 + j) * 33 + kp + 16 * i] = cvt_pk_bf16(a[j], b[j]);
    }
    __syncthreads();
    const int n = tid >> 2, c = tid & 3;
    u32x4 w0, w1;
    w0.x = ldsw[n * 33 + c * 8 + 0]; w0.y = ldsw[n * 33 + c * 8 + 1]; w0.z = ldsw[n * 33 + c * 8 + 2]; w0.w = ldsw[n * 33 + c * 8 + 3];
    w1.x = ldsw[n * 33 + c * 8 + 4]; w1.y = ldsw[n * 33 + c * 8 + 5]; w1.z = ldsw[n * 33 + c * 8 + 6]; w1.w = ldsw[n * 33 + c * 8 + 7];
    bf16_t* dp = t.dst + (size_t)(t.drow0 + n) * t.K + k0 + c * 16;
    *(u32x4*)dp = w0; *(u32x4*)(dp + 8) = w1;
    __syncthreads();
}

__device__ void phase_prep(const Params& P, unsigned char* shm) {
    unsigned* ldsw = (unsigned*)shm;
    unsigned char* ws = P.ws;
    const int tid = threadIdx.x, wid = tid >> 6, lane = tid & 63;
    if (blockIdx.x == 0 && tid == 0) *(unsigned*)(ws + OFF_QCTR) = 0u;
    for (size_t i = (size_t)blockIdx.x * 512 + tid; i < (SZ_HACC + SZ_GACC) / 16; i += (size_t)gridDim.x * 512) ((f32x4*)(ws + OFF_HACC))[i] = (f32x4){0.f, 0.f, 0.f, 0.f};
    if (blockIdx.x == 0 && wid == 1) {
        float aq = fmaxf(fabsf(P.a_q_g[lane]), fabsf(P.a_q_g[lane + 64])), ak = fmaxf(fabsf(P.a_k_g[lane]), fabsf(P.a_k_g[lane + 64]));
        float bq = fmaxf(fabsf(P.b_q_g[lane]), fabsf(P.b_q_g[lane + 64])), bk = 0.f, ta = 0.f, tb = 0.f;
        for (int i = lane; i < 384; i += 64) bk = fmaxf(bk, fabsf(P.b_k_g[i]));
        for (int i = lane; i < 1024; i += 64) { const float v = fabsf(P.rel_bias[i]); if ((i & 31) < 16) ta = fmaxf(ta, v); else tb = fmaxf(tb, v); }
        if (lane < 16) ta = fmaxf(ta, fabsf(P.a_sinks[lane]));
#pragma unroll
        for (int o = 32; o >= 1; o >>= 1) { aq = fmaxf(aq, __shfl_xor(aq, o)); ak = fmaxf(ak, __shfl_xor(ak, o)); bq = fmaxf(bq, __shfl_xor(bq, o)); bk = fmaxf(bk, __shfl_xor(bk, o)); ta = fmaxf(ta, __shfl_xor(ta, o)); tb = fmaxf(tb, __shfl_xor(tb, o)); }
        const float ra = 11.3137085f * LOG2E * aq * ak + LOG2E * ta + 1.0f, rb = 11.3137085f * LOG2E * bq * bk + LOG2E * tb + 1.0f;
        if (lane == 0) { float* mr = (float*)(ws + OFF_MREF); mr[0] = ra; mr[1] = rb; mr[2] = (ra < 60.0f && rb < 60.0f) ? 1.0f : 0.0f; }
    }
    for (int i = blockIdx.x * 512 + tid; i < S_; i += gridDim.x * 512) { ((float*)(ws + OFF_SS1))[i] = 0.f; ((float*)(ws + OFF_SSAB))[2 * i] = 0.f; ((float*)(ws + OFF_SSAB))[2 * i + 1] = 0.f; }
    for (int row = blockIdx.x * 8 + wid; row < S_; row += gridDim.x * 8) {
        const f32x4* xr = (const f32x4*)(P.x + (size_t)row * DM); bf16_t* xo = (bf16_t*)(ws + OFF_XB) + (size_t)row * DM; float ss = 0.f;
#pragma unroll 4
        for (int i = 0; i < 16; ++i) { const f32x4 v = xr[i * 64 + lane]; ss += (v[0] * v[0] + v[1] * v[1]) + (v[2] * v[2] + v[3] * v[3]);
            u32x2 w; w.x = cvt_pk_bf16(v[0], v[1]); w.y = cvt_pk_bf16(v[2], v[3]); *(u32x2*)(xo + (i * 64 + lane) * 4) = w; }
        ss = wave_sum(ss);
        if (lane == 0) ((float*)(ws + OFF_RSTD0))[row] = rsqrtf(ss * (1.0f / 4096.0f) + EPS_);
    }
    constexpr int J0 = 64 * 66, J1 = J0 + 64 * 32, J2 = J1 + 64 * 86, J3 = J2 + 64 * 86, J4 = J3 + 172 * 32, J5 = J4 + 128, J6 = J5 + 128;
    auto decode = [&](int it) -> TDesc {
        TDesc t;
        if (it < J0) { t = TDesc{P.w_in, P.norm_mix_g, (bf16_t*)(ws + OFF_WIN), 4096, NIN, it / 66, it % 66, (it % 66) * 128}; }
        else if (it < J1) { const int i = it - J0; t = TDesc{P.w_out, P.out_norm_g, (bf16_t*)(ws + OFF_WOUT), 4096, 4096, i / 32, i % 32, (i % 32) * 128}; }
        else if (it < J2) { const int i = it - J1; t = TDesc{P.w_gate, P.norm_ffn_g, (bf16_t*)(ws + OFF_WGU), 4096, DFF, i / 86, i % 86, (i % 86) * 256}; }
        else if (it < J3) { const int i = it - J2; t = TDesc{P.w_up, P.norm_ffn_g, (bf16_t*)(ws + OFF_WGU), 4096, DFF, i / 86, i % 86, (i % 86) * 256 + 128}; }
        else if (it < J4) { const int i = it - J3; t = TDesc{P.w_down, nullptr, (bf16_t*)(ws + OFF_WD), DFF, 4096, i / 32, i % 32, (i % 32) * 128}; }
        else if (it < J5) { const int i = it - J4; t = TDesc{P.cmp_w1, nullptr, (bf16_t*)(ws + OFF_W1), 4096, 256, i / 2, i % 2, (i % 2) * 128}; }
        else { const int i = it - J5; t = TDesc{P.cmp_w1 + 4096 * 256, nullptr, (bf16_t*)(ws + OFF_W1) + 256 * 4096, 4096, 256, i / 2, i % 2, (i % 2) * 128}; }
        return t;
    };
    {
        int it = blockIdx.x;
        if (it < J6) {
            TDesc tc = decode(it); TRegs rc; tconv_load(tc, rc);
            for (;;) {
                const int itn = it + gridDim.x; const bool more = itn < J6;
                TDesc tn = tc; TRegs rn = rc;
                if (more) { tn = decode(itn); tconv_load(tn, rn); }
                tconv_store(ldsw, tc, rc);
                if (!more) break;
                tc = tn; rc = rn; it = itn;
            }
        }
    }
}

__device__ __forceinline__ void norm_head(const bf16_t* src, bf16_t* dst, float g0, float g1, float scale, int lane) {
    const unsigned w = *(const unsigned*)(src + 2 * lane); float a = bf_lo(w), b = bf_hi(w);
    const float ss = wave_sum(a * a + b * b); const float r = rsqrtf(ss * (1.0f / 128.0f) + EPS_) * scale;
    *(unsigned*)(dst + 2 * lane) = cvt_pk_bf16(a * r * g0, b * r * g1);
}
__device__ void phase_norm(const Params& P, unsigned char* shm) {
    unsigned char* ws = P.ws; const bf16_t* proj = (const bf16_t*)(ws + OFF_PROJ);
    const int tid = threadIdx.x, wid = tid >> 6, lane = tid & 63;
    {
        bf16_t* T = (bf16_t*)shm;
        for (int it = blockIdx.x; it < 384; it += gridDim.x) {
            const int v = it >> 7, sb = it & 127, s0 = sb * 64;
            const int col = v == 0 ? 2560 : (v == 1 ? 6656 : 7680);
            bf16_t* dst = (bf16_t*)(ws + (v == 0 ? OFF_VA : (v == 1 ? OFF_VS : OFF_VW)));
#pragma unroll
            for (int i = 0; i < 8; ++i) { const int r = (tid >> 6) + 8 * i, ch = tid & 63;
                *(u32x4*)(T + r * 520 + ch * 8) = *(const u32x4*)(proj + (size_t)(s0 + r) * NINP + col + ch * 8); }
            __syncthreads();
#pragma unroll
            for (int k = 0; k < 8; ++k) { unsigned w[4];
#pragma unroll
                for (int e = 0; e < 4; ++e) w[e] = (unsigned)T[(8 * k + 2 * e) * 520 + tid] | ((unsigned)T[(8 * k + 2 * e + 1) * 520 + tid] << 16);
                u32x4 o; o.x = w[0]; o.y = w[1]; o.z = w[2]; o.w = w[3];
                *(u32x4*)(dst + (size_t)tid * S_ + s0 + 8 * k) = o; }
            __syncthreads();
        }
    }
    {
        const int sub = lane >> 4, e8 = (lane & 15) * 8;
        float gaq[8], gak[8], gbq[8], gks[8], gkw[8];
#pragma unroll
        for (int j = 0; j < 8; ++j) { gaq[j] = P.a_q_g[e8 + j] * QSCALE; gak[j] = P.a_k_g[e8 + j]; gbq[j] = P.b_q_g[e8 + j] * QSCALE; gks[j] = P.b_k_g[128 + e8 + j]; gkw[j] = P.b_k_g[256 + e8 + j]; }
        for (int s = blockIdx.x * 8 + wid; s < S_; s += gridDim.x * 8) {
            const bf16_t* pr = proj + (size_t)s * NINP;
#pragma unroll
            for (int grp = 0; grp < 11; ++grp) {
                const int scol = grp < 4 ? grp * 512 : (grp == 4 ? 2048 : (grp < 9 ? 3072 + (grp - 5) * 512 : (grp == 9 ? 6144 : 7168)));
                bf16_t* dst = grp < 4 ? (bf16_t*)(ws + OFF_QA) + (size_t)s * 2048 + grp * 512 : (grp == 4 ? (bf16_t*)(ws + OFF_KA) + (size_t)s * 512 :
                              (grp < 9 ? (bf16_t*)(ws + OFF_QB) + (size_t)s * 2048 + (grp - 5) * 512 : (grp == 9 ? (bf16_t*)(ws + OFF_KS) + (size_t)s * 512 : (bf16_t*)(ws + OFF_KW) + (size_t)s * 512)));
                const u32x4 w = *(const u32x4*)(pr + scol + sub * 128 + e8);
                float v[8]; v[0] = bf_lo(w.x); v[1] = bf_hi(w.x); v[2] = bf_lo(w.y); v[3] = bf_hi(w.y); v[4] = bf_lo(w.z); v[5] = bf_hi(w.z); v[6] = bf_lo(w.w); v[7] = bf_hi(w.w);
                float ss = ((v[0] * v[0] + v[1] * v[1]) + (v[2] * v[2] + v[3] * v[3])) + ((v[4] * v[4] + v[5] * v[5]) + (v[6] * v[6] + v[7] * v[7]));
                ss += __shfl_xor(ss, 8); ss += __shfl_xor(ss, 4); ss += __shfl_xor(ss, 2); ss += __shfl_xor(ss, 1);
                const float r = rsqrtf(ss * (1.0f / 128.0f) + EPS_);
                u32x4 o;
                if (grp < 4) { o.x = cvt_pk_bf16(v[0] * r * gaq[0], v[1] * r * gaq[1]); o.y = cvt_pk_bf16(v[2] * r * gaq[2], v[3] * r * gaq[3]); o.z = cvt_pk_bf16(v[4] * r * gaq[4], v[5] * r * gaq[5]); o.w = cvt_pk_bf16(v[6] * r * gaq[6], v[7] * r * gaq[7]); }
                else if (grp == 4) { o.x = cvt_pk_bf16(v[0] * r * gak[0], v[1] * r * gak[1]); o.y = cvt_pk_bf16(v[2] * r * gak[2], v[3] * r * gak[3]); o.z = cvt_pk_bf16(v[4] * r * gak[4], v[5] * r * gak[5]); o.w = cvt_pk_bf16(v[6] * r * gak[6], v[7] * r * gak[7]); }
                else if (grp < 9) { o.x = cvt_pk_bf16(v[0] * r * gbq[0], v[1] * r * gbq[1]); o.y = cvt_pk_bf16(v[2] * r * gbq[2], v[3] * r * gbq[3]); o.z = cvt_pk_bf16(v[4] * r * gbq[4], v[5] * r * gbq[5]); o.w = cvt_pk_bf16(v[6] * r * gbq[6], v[7] * r * gbq[7]); }
                else if (grp == 9) { o.x = cvt_pk_bf16(v[0] * r * gks[0], v[1] * r * gks[1]); o.y = cvt_pk_bf16(v[2] * r * gks[2], v[3] * r * gks[3]); o.z = cvt_pk_bf16(v[4] * r * gks[4], v[5] * r * gks[5]); o.w = cvt_pk_bf16(v[6] * r * gks[6], v[7] * r * gks[7]); }
                else { o.x = cvt_pk_bf16(v[0] * r * gkw[0], v[1] * r * gkw[1]); o.y = cvt_pk_bf16(v[2] * r * gkw[2], v[3] * r * gkw[3]); o.z = cvt_pk_bf16(v[4] * r * gkw[4], v[5] * r * gkw[5]); o.w = cvt_pk_bf16(v[6] * r * gkw[6], v[7] * r * gkw[7]); }
                *(u32x4*)(dst + sub * 128 + e8) = o;
            }
        }
    }
    {
        bf16_t* im = (bf16_t*)(ws + OFF_IM2);
        for (int r = blockIdx.x * 8 + wid; r < 4096; r += gridDim.x * 8) {
            const int c = r >> 11, g = (r >> 9) & 3, n = r & 511, colc = (c ? 5632 : 5120) + g * 128;
            const int sub = lane >> 4, ch = lane & 15;
#pragma unroll
            for (int itx = 0; itx < 8; ++itx) { const int l = itx * 4 + sub; u32x4 v = {0u, 0u, 0u, 0u};
                if (n < 511) { const u32x4 t = *(const u32x4*)(proj + (size_t)(16 * n + l) * NINP + colc + ch * 8);
                    const f32x4 p0 = *(const f32x4*)(P.pos_emb + (size_t)c * 4096 + l * 128 + ch * 8), p1 = *(const f32x4*)(P.pos_emb + (size_t)c * 4096 + l * 128 + ch * 8 + 4);
                    v.x = cvt_pk_bf16(bf_lo(t.x) + p0[0], bf_hi(t.x) + p0[1]); v.y = cvt_pk_bf16(bf_lo(t.y) + p0[2], bf_hi(t.y) + p0[3]);
                    v.z = cvt_pk_bf16(bf_lo(t.z) + p1[0], bf_hi(t.z) + p1[1]); v.w = cvt_pk_bf16(bf_lo(t.w) + p1[2], bf_hi(t.w) + p1[3]); }
                *(u32x4*)(im + (size_t)r * 4096 + l * 128 + ch * 8) = v; }
        }
    }
}

__device__ void phase_cmp2(const Params& P, unsigned char* shm) {
    unsigned char* ws = P.ws; const int tid = threadIdx.x, wid = tid >> 6, lane = tid & 63;
    const float* Hacc = (const float*)(ws + OFF_HACC);
    float* hl = (float*)shm + wid * 512;
    for (int rp = blockIdx.x * 8 + wid; rp < 2048; rp += gridDim.x * 8) {
        const int r = rp * 2, c = r >> 11, g = (r >> 9) & 3, n = r & 511;
        const f32x4 bb = *(const f32x4*)(P.cmp_b1 + c * 256 + 4 * lane);
#pragma unroll
        for (int rr = 0; rr < 2; ++rr) { f32x4 v = *(const f32x4*)(Hacc + (size_t)(r + rr) * 256 + 4 * lane) + bb;
#pragma unroll
            for (int j = 0; j < 4; ++j) { const float a = v[j]; v[j] = __uint_as_float(cvt_pk_bf16(a * __builtin_amdgcn_rcpf(1.0f + __expf(-1.5957691216057308f * (a + 0.044715f * a * a * a))), 0.f) << 16); }
            *(f32x4*)(hl + rr * 256 + 4 * lane) = v; }
        const float* w2 = P.cmp_w2 + (size_t)c * 256 * 128 + 2 * lane;
        float a0 = P.cmp_b2[c * 128 + 2 * lane], a1 = P.cmp_b2[c * 128 + 2 * lane + 1], b0 = a0, b1 = a1;
#pragma unroll 8
        for (int k = 0; k < 256; ++k) { const float h0 = hl[k], h1 = hl[256 + k];
            const float2 w = *(const float2*)(w2 + (size_t)k * 128); a0 += h0 * w.x; a1 += h0 * w.y; b0 += h1 * w.x; b1 += h1 * w.y; }
        if (c == 0) {
            const float gk0 = P.b_k_g[2 * lane], gk1 = P.b_k_g[2 * lane + 1];
            const float ra = rsqrtf(wave_sum(a0 * a0 + a1 * a1) * (1.0f / 128.0f) + EPS_), rb = rsqrtf(wave_sum(b0 * b0 + b1 * b1) * (1.0f / 128.0f) + EPS_);
            bf16_t* kc = (bf16_t*)(ws + OFF_KC) + ((size_t)g * 512 + n) * 128 + 2 * lane;
            *(unsigned*)kc = cvt_pk_bf16(a0 * ra * gk0, a1 * ra * gk1); *(unsigned*)(kc + 128) = cvt_pk_bf16(b0 * rb * gk0, b1 * rb * gk1);
        } else {
            bf16_t* vt = (bf16_t*)(ws + OFF_VCT) + ((size_t)g * 128 + 2 * lane) * 512 + n;
            *(unsigned*)vt = cvt_pk_bf16(a0, b0); *(unsigned*)(vt + 512) = cvt_pk_bf16(a1, b1);
        }
    }
}

constexpr int AL_K = 0, AL_V = 16384, AL_BUF = 32768, AL_BIAS = 65536, AL_SC = 67840, AL_FS = 133376;
#define NEG_INF (-__builtin_inff())

template <int MODE, int PASS>
__device__ __forceinline__ void attn_tiles(unsigned char* shm, const bf16_t* kbase, int kstride, const bf16_t* vbase, int vstride, int kt_lo, int kt_hi,
                                           const bf16x8 (&qf)[2][4], float (&m_)[2], float (&l_)[2], const float (&inv2)[2], f32x4 (&O)[2][8],
                                           unsigned sm0, unsigned sm1, unsigned sm2, unsigned sm3, int query, int hp, int qs, int qlo, int hb0, int hb1, bool stats3) {
    const bool stats = (MODE != 2) && stats3;
    constexpr bool FIX = (MODE != 2) && (PASS == 0);
    const int tid = threadIdx.x, lane = tid & 63, n = lane & 15, qq = lane >> 4;
    const float* biasL = (const float*)(shm + AL_BIAS);
    const float bfar0 = biasL[hb0 * 132 + 128], bfar1 = biasL[hb1 * 132 + 128];
    float carry = 0.f;
    const int wid_ = __builtin_amdgcn_readfirstlane(tid >> 6);
    PG8_LAS unsigned char* shmL = (PG8_LAS unsigned char*)shm;
#define ATT_DMA(KT, B) do { const int key0_ = (KT) * 64; _Pragma("unroll") for (int i = 0; i < 2; ++i) { const int ci = wid_ * 2 + i; \
        const int r_ = 4 * ci + (lane >> 4), c_ = (lane & 15) ^ (r_ & 15); \
        __builtin_amdgcn_global_load_lds((const unsigned*)(kbase + (size_t)(key0_ + r_) * kstride + c_ * 8), (PG8_LAS unsigned*)(shmL + (B) * AL_BUF + AL_K + ci * 1024), 16, 0, 0); \
        const int d_ = 8 * ci + (lane >> 3), s_ = (lane & 7) ^ ((d_ >> 1) & 7); \
        __builtin_amdgcn_global_load_lds((const unsigned*)(vbase + (size_t)d_ * vstride + key0_ + s_ * 8), (PG8_LAS unsigned*)(shmL + (B) * AL_BUF + AL_V + ci * 1024), 16, 0, 0); } } while (0)
    ATT_DMA(kt_lo, 0);
    asm volatile("s_waitcnt vmcnt(0)" ::: "memory");
    __syncthreads();
#pragma unroll 1
    for (int kt = kt_lo; kt <= kt_hi; ++kt) {
        const int cur = (kt - kt_lo) & 1;
        if (kt < kt_hi) ATT_DMA(kt + 1, cur ^ 1);
        const unsigned char* kl = shm + cur * AL_BUF + AL_K; const unsigned char* vl = shm + cur * AL_BUF + AL_V;
        const int key0 = kt * 64;
        bool selb = true;
        if (MODE == 3) { const unsigned w = kt < 32 ? sm0 : (kt < 64 ? sm1 : (kt < 96 ? sm2 : sm3)); selb = (w >> (kt & 31)) & 1u; }
        bool doit = true;
        if (MODE == 3) doit = __ballot(selb) != 0ull;
        if (doit) {
            f32x4 Sx[2][4];
#pragma unroll
            for (int tq = 0; tq < 2; ++tq)
#pragma unroll
                for (int st = 0; st < 4; ++st) Sx[tq][st] = (f32x4){0.f, 0.f, 0.f, 0.f};
#pragma unroll
            for (int st = 0; st < 4; ++st)
#pragma unroll
                for (int dc = 0; dc < 4; ++dc) {
                    const bf16x8 kf = *(const bf16x8*)(kl + (st * 16 + n) * 256 + (((dc * 4 + qq) ^ n) * 16));
                    Sx[0][st] = __builtin_amdgcn_mfma_f32_16x16x32_bf16(kf, qf[0][dc], Sx[0][st], 0, 0, 0);
                    Sx[1][st] = __builtin_amdgcn_mfma_f32_16x16x32_bf16(kf, qf[1][dc], Sx[1][st], 0, 0, 0);
                }
            const int dmin = (MODE == 2) ? qlo - (16 * (key0 + 63) + 31) : qlo - (key0 + 63);
            const int dmax = (MODE == 2) ? qlo + 15 - (16 * key0 + 31) : qlo + 15 - key0;
            const bool fast = (MODE != 0) && dmin >= 128 && (MODE != 1 || dmax < 512);
            if (fast) {
#pragma unroll
                for (int tq = 0; tq < 2; ++tq) {
                    const float bc = tq ? bfar1 : bfar0;
                    if (FIX && stats) {
                        float tm = fmaxf(fmaxf(fmaxf(Sx[tq][0][0], Sx[tq][0][1]), fmaxf(Sx[tq][0][2], Sx[tq][0][3])), fmaxf(fmaxf(Sx[tq][1][0], Sx[tq][1][1]), fmaxf(Sx[tq][1][2], Sx[tq][1][3])));
                        tm = fmaxf(tm, fmaxf(fmaxf(fmaxf(Sx[tq][2][0], Sx[tq][2][1]), fmaxf(Sx[tq][2][2], Sx[tq][2][3])), fmaxf(fmaxf(Sx[tq][3][0], Sx[tq][3][1]), fmaxf(Sx[tq][3][2], Sx[tq][3][3]))));
                        tm = (MODE == 3 && !selb) ? NEG_INF : tm + bc;
                        tm = fmaxf(tm, __shfl_xor(tm, 16)); tm = fmaxf(tm, __shfl_xor(tm, 32));
                        m_[tq] = fmaxf(m_[tq], tm);
                    } else if ((PASS != 2 && FIX) || (MODE == 2 && PASS == 1 && stats3)) {
                        const float cc = (MODE == 3 && !selb) ? NEG_INF : bc - m_[tq];
                        float ps = 0.f;
#pragma unroll
                        for (int st = 0; st < 4; ++st)
#pragma unroll
                            for (int r = 0; r < 4; ++r) { const float p = __builtin_amdgcn_exp2f(Sx[tq][st][r] + cc); Sx[tq][st][r] = p; ps += p; }
                        l_[tq] += ps;
                    } else if (PASS != 2) {
                        float tm = fmaxf(fmaxf(fmaxf(Sx[tq][0][0], Sx[tq][0][1]), fmaxf(Sx[tq][0][2], Sx[tq][0][3])), fmaxf(fmaxf(Sx[tq][1][0], Sx[tq][1][1]), fmaxf(Sx[tq][1][2], Sx[tq][1][3])));
                        tm = fmaxf(tm, fmaxf(fmaxf(fmaxf(Sx[tq][2][0], Sx[tq][2][1]), fmaxf(Sx[tq][2][2], Sx[tq][2][3])), fmaxf(fmaxf(Sx[tq][3][0], Sx[tq][3][1]), fmaxf(Sx[tq][3][2], Sx[tq][3][3]))));
                        tm = (MODE == 3 && !selb) ? NEG_INF : tm + bc;
                        tm = fmaxf(tm, __shfl_xor(tm, 16)); tm = fmaxf(tm, __shfl_xor(tm, 32));
                        const float mn = fmaxf(m_[tq], tm), mu = (mn == NEG_INF) ? 0.f : mn;
                        const float alpha = __builtin_amdgcn_exp2f(m_[tq] - mu);
                        m_[tq] = mn;
                        const float cc = (MODE == 3 && !selb) ? NEG_INF : bc - mu;
                        float ps = 0.f;
#pragma unroll
                        for (int st = 0; st < 4; ++st)
#pragma unroll
                            for (int r = 0; r < 4; ++r) { const float p = __builtin_amdgcn_exp2f(Sx[tq][st][r] + cc); Sx[tq][st][r] = p; ps += p; }
                        l_[tq] = l_[tq] * alpha + ps;
                        if (PASS == 0) { if (__ballot(alpha != 1.0f) != 0ull) {
#pragma unroll
                            for (int dt = 0; dt < 8; ++dt) O[tq][dt] = O[tq][dt] * alpha; } }
                    } else {
                        const float mu = (m_[tq] == NEG_INF) ? 0.f : m_[tq]; const float cc = bc - mu;
#pragma unroll
                        for (int st = 0; st < 4; ++st)
#pragma unroll
                            for (int r = 0; r < 4; ++r) Sx[tq][st][r] = __builtin_amdgcn_exp2f(Sx[tq][st][r] + cc) * inv2[tq];
                    }
                }
            } else {
#pragma unroll
                for (int st = 0; st < 4; ++st)
#pragma unroll
                    for (int r = 0; r < 4; ++r) {
                        const int key = key0 + st * 16 + qq * 4 + r;
                        const int dist = (MODE == 2) ? query - (16 * key + 31) : query - key;
                        bool valid = dist >= 0;
                        if (MODE == 0) valid = valid && dist < 128;
                        if (MODE == 1) valid = valid && dist < 512;
                        if (MODE == 3) valid = valid && selb;
                        int idx = dist < 0 ? 0 : dist; idx = idx > 128 ? 128 : idx;
                        const float b0 = biasL[hb0 * 132 + idx], b1 = biasL[hb1 * 132 + idx];
                        Sx[0][st][r] = valid ? Sx[0][st][r] + b0 : NEG_INF;
                        Sx[1][st][r] = valid ? Sx[1][st][r] + b1 : NEG_INF;
                    }
#pragma unroll
                for (int tq = 0; tq < 2; ++tq) {
                    if (FIX && stats) {
                        float tm = NEG_INF;
#pragma unroll
                        for (int st = 0; st < 4; ++st)
#pragma unroll
                            for (int r = 0; r < 4; ++r) tm = fmaxf(tm, Sx[tq][st][r]);
                        tm = fmaxf(tm, __shfl_xor(tm, 16)); tm = fmaxf(tm, __shfl_xor(tm, 32));
                        m_[tq] = fmaxf(m_[tq], tm);
                    } else if ((PASS != 2 && FIX) || (MODE == 2 && PASS == 1 && stats3)) {
                        float ps = 0.f;
#pragma unroll
                        for (int st = 0; st < 4; ++st)
#pragma unroll
                            for (int r = 0; r < 4; ++r) { const float p = __builtin_amdgcn_exp2f(Sx[tq][st][r] - m_[tq]); Sx[tq][st][r] = p; ps += p; }
                        l_[tq] += ps;
                    } else if (PASS != 2) {
                        float tm = NEG_INF;
#pragma unroll
                        for (int st = 0; st < 4; ++st)
#pragma unroll
                            for (int r = 0; r < 4; ++r) tm = fmaxf(tm, Sx[tq][st][r]);
                        tm = fmaxf(tm, __shfl_xor(tm, 16)); tm = fmaxf(tm, __shfl_xor(tm, 32));
                        const float mn = fmaxf(m_[tq], tm), mu = (mn == NEG_INF) ? 0.f : mn;
                        const float alpha = __builtin_amdgcn_exp2f(m_[tq] - mu);
                        m_[tq] = mn;
                        float ps = 0.f;
#pragma unroll
                        for (int st = 0; st < 4; ++st)
#pragma unroll
                            for (int r = 0; r < 4; ++r) { const float p = __builtin_amdgcn_exp2f(Sx[tq][st][r] - mu); Sx[tq][st][r] = p; ps += p; }
                        l_[tq] = l_[tq] * alpha + ps;
                        if (PASS == 0) {
#pragma unroll
                            for (int dt = 0; dt < 8; ++dt) O[tq][dt] = O[tq][dt] * alpha;
                        }
                    } else {
                        const float mu = (m_[tq] == NEG_INF) ? 0.f : m_[tq];
#pragma unroll
                        for (int st = 0; st < 4; ++st)
#pragma unroll
                            for (int r = 0; r < 4; ++r) Sx[tq][st][r] = __builtin_amdgcn_exp2f(Sx[tq][st][r] - mu) * inv2[tq];
                    }
                }
            }
            if (PASS == 2) {
                float* scL = (float*)(shm + AL_SC) + hp * 128 * 64 + qs * 16 + n;
                float yprev = carry;
#pragma unroll
                for (int st = 0; st < 4; ++st) {
                    const float a = ((Sx[0][st][0] + Sx[0][st][1]) + (Sx[0][st][2] + Sx[0][st][3])) + ((Sx[1][st][0] + Sx[1][st][1]) + (Sx[1][st][2] + Sx[1][st][3]));
                    const float y = __shfl(Sx[0][st][3] + Sx[1][st][3], (lane + 48) & 63);
                    scL[(16 * kt + 4 * st + qq) * 64] = a + ((qq > 0) ? y : yprev);
                    yprev = y;
                }
                carry = yprev;
            }
            if (PASS != 1 && !stats) {
                bf16x8 pb[2][2];
#pragma unroll
                for (int tq = 0; tq < 2; ++tq)
#pragma unroll
                    for (int ch = 0; ch < 2; ++ch) { u32x4 w; w.x = cvt_pk_bf16(Sx[tq][2 * ch][0], Sx[tq][2 * ch][1]); w.y = cvt_pk_bf16(Sx[tq][2 * ch][2], Sx[tq][2 * ch][3]);
                        w.z = cvt_pk_bf16(Sx[tq][2 * ch + 1][0], Sx[tq][2 * ch + 1][1]); w.w = cvt_pk_bf16(Sx[tq][2 * ch + 1][2], Sx[tq][2 * ch + 1][3]); pb[tq][ch] = __builtin_bit_cast(bf16x8, w); }
#pragma unroll
                for (int dt = 0; dt < 8; ++dt)
#pragma unroll
                    for (int ch = 0; ch < 2; ++ch) {
                        const unsigned char* vp = vl + (dt * 16 + n) * 128 + (qq & 1) * 8;
                        const u32x2 lo = *(const u32x2*)(vp + (((4 * ch + (qq >> 1)) ^ (n >> 1)) * 16)), hi = *(const u32x2*)(vp + (((4 * ch + 2 + (qq >> 1)) ^ (n >> 1)) * 16));
                        u32x4 vv; vv.x = lo.x; vv.y = lo.y; vv.z = hi.x; vv.w = hi.y;
                        const bf16x8 vf = __builtin_bit_cast(bf16x8, vv);
                        O[0][dt] = __builtin_amdgcn_mfma_f32_16x16x32_bf16(vf, pb[0][ch], O[0][dt], 0, 0, 0);
                        O[1][dt] = __builtin_amdgcn_mfma_f32_16x16x32_bf16(vf, pb[1][ch], O[1][dt], 0, 0, 0);
                    }
            }
        }
        asm volatile("s_waitcnt vmcnt(0)" ::: "memory");
        __syncthreads();
    }
#undef ATT_DMA
}

template <int MODE>
__device__ void attn_item(const Params& P, unsigned char* shm, int qb, int g, int dry, bool refill = true) {
    unsigned char* ws = P.ws;
    const int tid = threadIdx.x, wid = tid >> 6, lane = tid & 63, n = lane & 15, qq = lane >> 4;
    const int qs = wid >> 1, hp = wid & 1;
    const int s0 = qb * 64, query = (MODE == 3) ? s0 + wid * 8 + (n >> 1) : s0 + qs * 16 + n;
    const int hb0 = (MODE == 3) ? (n & 1) : 2 * hp, hb1 = (MODE == 3) ? 2 + (n & 1) : 2 * hp + 1;
    const int qlo = (MODE == 3) ? s0 + wid * 8 : s0 + qs * 16;
    const bf16_t* qbuf = (const bf16_t*)(ws + (MODE == 0 ? OFF_QA : OFF_QB));
    const bf16_t* kbase; const bf16_t* vbase; int kstride, vstride;
    if (MODE == 0) { kbase = (const bf16_t*)(ws + OFF_KA) + g * 128; kstride = 512; vbase = (const bf16_t*)(ws + OFF_VA) + (size_t)g * 128 * S_; vstride = S_; }
    else if (MODE == 1) { kbase = (const bf16_t*)(ws + OFF_KW) + g * 128; kstride = 512; vbase = (const bf16_t*)(ws + OFF_VW) + (size_t)g * 128 * S_; vstride = S_; }
    else if (MODE == 3) { kbase = (const bf16_t*)(ws + OFF_KS) + g * 128; kstride = 512; vbase = (const bf16_t*)(ws + OFF_VS) + (size_t)g * 128 * S_; vstride = S_; }
    else { kbase = (const bf16_t*)(ws + OFF_KC) + (size_t)g * 512 * 128; kstride = 128; vbase = (const bf16_t*)(ws + OFF_VCT) + (size_t)g * 128 * 512; vstride = 512; }
    const int hbase = g * 4;
    float* biasL = (float*)(shm + AL_BIAS);
    __syncthreads();
    if (refill) {
        for (int i = tid; i < 4 * 129; i += 512) { const int hh = i / 129, d = i - hh * 129; biasL[hh * 132 + d] = P.rel_bias[(int)T5B[d] * 32 + (MODE == 0 ? 0 : 16) + g * 4 + hh] * LOG2E; }
        __syncthreads();
    }
    bf16x8 qf[2][4];
#pragma unroll
    for (int tq = 0; tq < 2; ++tq)
#pragma unroll
        for (int dc = 0; dc < 4; ++dc) qf[tq][dc] = *(const bf16x8*)(qbuf + (size_t)query * 2048 + (hbase + (tq ? hb1 : hb0)) * 128 + dc * 32 + qq * 8);
    const float mref = ((const float*)(ws + OFF_MREF))[MODE == 0 ? 0 : 1]; const bool fixok = ((const float*)(ws + OFF_MREF))[2] != 0.f; const bool fix = (MODE != 2) && fixok;
    float m_[2], l_[2];
#pragma unroll
    for (int tq = 0; tq < 2; ++tq) {
        if (fix || (MODE == 2 && fixok)) { m_[tq] = mref; l_[tq] = (MODE == 0 && qq == 0) ? __builtin_amdgcn_exp2f(P.a_sinks[hbase + (tq ? hb1 : hb0)] * LOG2E - mref) : 0.0f; }
        else if (MODE == 0) { m_[tq] = P.a_sinks[hbase + (tq ? hb1 : hb0)] * LOG2E; l_[tq] = qq == 0 ? 1.0f : 0.0f; } else { m_[tq] = NEG_INF; l_[tq] = 0.f; } }
    unsigned sm0 = 0, sm1 = 0, sm2 = 0, sm3 = 0;
    if (MODE == 3) { const u32x4 w = *(const u32x4*)((const unsigned*)(ws + OFF_SEL) + ((size_t)g * S_ + query) * 4); sm0 = w.x; sm1 = w.y; sm2 = w.z; sm3 = w.w; }
    int kt_lo, kt_hi;
    if (MODE == 0) { kt_lo = qb - 2 < 0 ? 0 : qb - 2; kt_hi = qb; }
    else if (MODE == 1) { kt_lo = qb - 8 < 0 ? 0 : qb - 8; kt_hi = qb; }
    else if (MODE == 2) { kt_lo = 0; kt_hi = qb >> 4; }
    else { kt_lo = 0; kt_hi = qb; }
    float inv2[2] = {1.f, 1.f};
    f32x4 O[2][8];
    __builtin_amdgcn_s_waitcnt(0);
    if (MODE == 2) {
        attn_tiles<MODE, 1>(shm, kbase, kstride, vbase, vstride, kt_lo, kt_hi, qf, m_, l_, inv2, O, sm0, sm1, sm2, sm3, query, hp, qs, qlo, hb0, hb1, fixok);
#pragma unroll
        for (int tq = 0; tq < 2; ++tq) { float l = l_[tq]; l += __shfl_xor(l, 16); l += __shfl_xor(l, 32); inv2[tq] = l > 0.f ? 1.0f / l : 0.f; }
    }
#pragma unroll
    for (int tq = 0; tq < 2; ++tq)
#pragma unroll
        for (int dt = 0; dt < 8; ++dt) O[tq][dt] = (f32x4){0.f, 0.f, 0.f, 0.f};
#pragma unroll 1
    for (int sweep = (MODE != 2 && !fix) ? 0 : 1; sweep < 2; ++sweep) {
        if (MODE == 0 && sweep == 1 && !fix) {
#pragma unroll
            for (int tq = 0; tq < 2; ++tq) l_[tq] = qq == 0 ? __builtin_amdgcn_exp2f(P.a_sinks[hbase + (tq ? hb1 : hb0)] * LOG2E - m_[tq]) : 0.0f; }
        attn_tiles<MODE, (MODE == 2 ? 2 : 0)>(shm, kbase, kstride, vbase, vstride, kt_lo, kt_hi, qf, m_, l_, inv2, O, sm0, sm1, sm2, sm3, query, hp, qs, qlo, hb0, hb1, sweep == 0); }
    float* obuf = P.out;
    bf16_t* onb = (bf16_t*)(ws + OFF_ON);
    float ssq = 0.f;
    if (!(MODE >= 2 && dry))
#pragma unroll
    for (int tq = 0; tq < 2; ++tq) {
        float sc;
        if (MODE == 2) sc = 1.0f;
        else { float l = l_[tq]; l += __shfl_xor(l, 16); l += __shfl_xor(l, 32); sc = l > 0.f ? 1.0f / l : 0.f; }
        const int h = hbase + (tq ? hb1 : hb0);
        float gold = 1.0f;
        if (MODE >= 2) sc *= __builtin_amdgcn_rcpf(1.0f + __expf(-((const float*)(ws + OFF_GACC))[(size_t)query * 48 + h * 3 + (MODE == 2 ? 0 : 1)]));
        if (MODE == 2) gold = __builtin_amdgcn_rcpf(1.0f + __expf(-((const float*)(ws + OFF_GACC))[(size_t)query * 48 + h * 3 + 2]));
        float* op = obuf + (size_t)query * DM + (MODE == 0 ? 0 : 2048) + h * 128 + qq * 4;
        f32x4 oldv[8];
        if (MODE >= 2) {
#pragma unroll
            for (int dt = 0; dt < 8; ++dt) oldv[dt] = *(const f32x4*)(op + dt * 16);
        }
#pragma unroll
        for (int dt = 0; dt < 8; ++dt) { f32x4 v = O[tq][dt] * sc; if (MODE >= 2) v = v + oldv[dt] * gold;
            if (MODE == 0 || MODE == 3) {
                u32x2 w; w.x = cvt_pk_bf16(v[0], v[1]); w.y = cvt_pk_bf16(v[2], v[3]);
                *(u32x2*)(onb + (size_t)query * DM + (MODE == 0 ? 0 : 2048) + h * 128 + qq * 4 + dt * 16) = w;
                ssq += (v[0] * v[0] + v[1] * v[1]) + (v[2] * v[2] + v[3] * v[3]);
            } else *(f32x4*)(op + dt * 16) = v; }
    }
    if ((MODE == 0 || MODE == 3) && !(MODE >= 2 && dry)) {
        ssq += __shfl_xor(ssq, 16); ssq += __shfl_xor(ssq, 32);
        if (MODE == 3) ssq += __shfl_xor(ssq, 1);
        if (qq == 0 && (MODE != 3 || (n & 1) == 0)) atomicAdd((float*)(ws + OFF_SSAB) + 2 * query + (MODE == 0 ? 0 : 1), ssq);
    }
    if (MODE == 2) {
        __syncthreads();
        const float* sc0 = (const float*)(shm + AL_SC); float* fs = (float*)(shm + AL_FS) + wid * 128;
        const int cur = qb, j0 = lane, j1 = lane + 64;
        for (int e = 0; e < 8; ++e) {
            const int ql = wid * 8 + e;
            float v0 = -1.f, v1 = -1.f;
            if (j0 <= cur) { v0 = sc0[j0 * 64 + ql] + sc0[(128 + j0) * 64 + ql]; if (j0 == 0 || j0 == cur || j0 == cur - 1) v0 = 1e6f; }
            if (j1 <= cur) { v1 = sc0[j1 * 64 + ql] + sc0[(128 + j1) * 64 + ql]; if (j1 == cur || j1 == cur - 1) v1 = 1e6f; }
            fs[j0] = v0; fs[j1] = v1;
            __builtin_amdgcn_wave_barrier();
            int r0 = 0, r1 = 0;
            for (int jj = 0; jj <= cur; ++jj) { const float o = fs[jj]; r0 += (o > v0 || (o == v0 && jj < j0)) ? 1 : 0; r1 += (o > v1 || (o == v1 && jj < j1)) ? 1 : 0; }
            const unsigned long long b0 = __ballot(j0 <= cur && r0 < 16), b1 = __ballot(j1 <= cur && r1 < 16);
            if (lane == 0) { u32x4 w; w.x = (unsigned)b0; w.y = (unsigned)(b0 >> 32); w.z = (unsigned)b1; w.w = (unsigned)(b1 >> 32);
                *(u32x4*)((unsigned*)(ws + OFF_SEL) + ((size_t)g * S_ + s0 + ql) * 4) = w; }
            __builtin_amdgcn_wave_barrier();
        }
    }
}
template <int MODE>
__device__ __forceinline__ void attn_phase(const Params& P, unsigned char* shm, int dry, int first = -1, int stride = 0) {
    if (first < 0) { first = blockIdx.x; stride = gridDim.x; }
    for (int it = first; it < 512; it += stride) {
        const int j = it & 255, g = (j & 7) >> 1, li = ((j & 1) << 5) | (j >> 3); const int qb = it < 256 ? li : 127 - li;
        attn_item<MODE>(P, shm, qb, g, dry);
    }
}

__device__ void phase_outnorm(const Params& P) {
    const int tid = threadIdx.x, wid = tid >> 6, lane = tid & 63;
    bf16_t* on = (bf16_t*)(P.ws + OFF_ON);
    for (int s = blockIdx.x * 8 + wid; s < S_; s += gridDim.x * 8) {
        const f32x4* r = (const f32x4*)(P.out + (size_t)s * DM);
#pragma unroll
        for (int grp = 0; grp < 2; ++grp) {
            f32x4 v[8]; float ss = 0.f;
#pragma unroll
            for (int i = 0; i < 8; ++i) { v[i] = r[grp * 512 + i * 64 + lane]; ss += (v[i][0] * v[i][0] + v[i][1] * v[i][1]) + (v[i][2] * v[i][2] + v[i][3] * v[i][3]); }
            ss = wave_sum(ss); const float rr = rsqrtf(ss * (1.0f / 2048.0f) + EPS_);
#pragma unroll
            for (int i = 0; i < 8; ++i) { u32x2 w; w.x = cvt_pk_bf16(v[i][0] * rr, v[i][1] * rr); w.y = cvt_pk_bf16(v[i][2] * rr, v[i][3] * rr);
                *(u32x2*)(on + (size_t)s * DM + (grp * 512 + i * 64 + lane) * 4) = w; }
        }
    }
}

__device__ __forceinline__ void cmp_slc_phase(const Params& P, unsigned char* shm, int dry) {
    int prev_g = -1;
    for (int it = blockIdx.x; it < 512; it += gridDim.x) {
        const int j = it & 255, g = (j & 7) >> 1, li = ((j & 1) << 5) | (j >> 3); const int qb = it < 256 ? li : 127 - li;
        attn_item<2>(P, shm, qb, g, dry, g != prev_g); prev_g = g;
        __builtin_amdgcn_fence(__ATOMIC_RELEASE, "workgroup"); __syncthreads(); __builtin_amdgcn_fence(__ATOMIC_ACQUIRE, "workgroup");
        attn_item<3>(P, shm, qb, g, dry, false);
    }
}

__device__ void phase_fixup(const Params& P, int pm_only, int first, int stride) {
    const float* stL = (const float*)(P.ws + OFF_STL); const float* stG = (const float*)(P.ws + OFF_STG); const float* stU = (const float*)(P.ws + OFF_STU);
    bf16_t* hf = (bf16_t*)(P.ws + OFF_HF);
    constexpr int NC4 = DFF / 4;
    const int nit = pm_only < 0 ? 64 * NC4 : 2 * NC4;
    for (int it = first; it < nit; it += stride) {
        const int c4 = it % NC4, pr = it / NC4 + (pm_only < 0 ? 0 : 2 * pm_only), rr = pr & 1, pm = pr >> 1, col = c4 * 4;
        f32x4 L0 = {0.f, 0.f, 0.f, 0.f}, L1 = {0.f, 0.f, 0.f, 0.f};
        if (pm > 0) { L0 = *(const f32x4*)(stL + ((size_t)(pm - 1) * 2 + 0) * DFF + col); L1 = *(const f32x4*)(stL + ((size_t)(pm - 1) * 2 + 1) * DFF + col); }
        const f32x4 F0 = *(const f32x4*)(stG + ((size_t)pm * 2 + 0) * DFF + col), F1 = *(const f32x4*)(stG + ((size_t)pm * 2 + 1) * DFF + col);
        const f32x4 uu = *(const f32x4*)(stU + ((size_t)pm * 2 + rr) * DFF + col);
        const f32x4 g2 = rr ? L1 : L0, g1 = rr ? F0 : L1, g0 = rr ? F1 : F0;
        const f32x4 w0 = *(const f32x4*)(P.conv_w + col), w1 = *(const f32x4*)(P.conv_w + DFF + col), w2 = *(const f32x4*)(P.conv_w + 2 * DFF + col), cb = *(const f32x4*)(P.conv_b + col);
        const f32x4 z = cb + w0 * g2 + w1 * g1 + w2 * g0;
        f32x4 hv;
#pragma unroll
        for (int j = 0; j < 4; ++j) hv[j] = z[j] * __builtin_amdgcn_rcpf(1.0f + __expf(-z[j])) * uu[j];
        u32x2 w; w.x = cvt_pk_bf16(hv[0], hv[1]); w.y = cvt_pk_bf16(hv[2], hv[3]);
        *(u32x2*)(hf + (size_t)(pm * 256 + rr) * DFF + col) = w;
    }
}

__device__ __forceinline__ void phase3(const Params& P, unsigned char* shm, int dry) {
    unsigned char* ws = P.ws; const int b = blockIdx.x, G = gridDim.x;
    if (b < 64) {
        const int kh = b >> 5; pg8::Gemm g{(const bf16_t*)(ws + OFF_IM2) + kh * 2048, (const bf16_t*)(ws + OFF_W1) + kh * 2048, 4096, 512, 2048, 4096}; pg8::StaticOrder so; so.init(4096, 512, 32, b & 31);
        pg8::Unit u0; const bool useful = so.next(0, u0) && (u0.pm >> 3) == u0.pn;
        if (useful) { EpiCmp e{(float*)(ws + OFF_HACC)}; pg8::gemm_phase<EpiCmp, pg8::StaticOrder, false>((PG8_LAS unsigned char*)shm, g, so, e, nullptr); } }
    else if (b < 128) {
        const int kh = (b - 64) >> 5; pg8::Gemm g{(const bf16_t*)(ws + OFF_XB) + kh * 2048, (const bf16_t*)(ws + OFF_WIN) + (size_t)8192 * DM + kh * 2048, S_, 256, 2048, 4096}; pg8::StaticOrder so; so.init(S_, 256, 32, (b - 64) & 31);
        EpiGates e{(float*)(ws + OFF_GACC), (const float*)(ws + OFF_RSTD0)}; pg8::gemm_phase<EpiGates, pg8::StaticOrder, false>((PG8_LAS unsigned char*)shm, g, so, e, nullptr); }
    unsigned* ctr = (unsigned*)(ws + OFF_QCTR);
    volatile LAS unsigned* qw = (volatile LAS unsigned*)(LAS unsigned char*)(shm + LDS_STAGE + 64);
    unsigned nxt = 0;
    if (threadIdx.x == 0) nxt = atomicAdd(ctr, 1u);
    for (;;) {
        __syncthreads();
        if (threadIdx.x == 0) qw[0] = nxt;
        __syncthreads();
        const int it = (int)qw[0];
        if (it >= 1024) break;
        if (threadIdx.x == 0) nxt = atomicAdd(ctr, 1u);
        const int i5 = it & 511, j = i5 & 255, g = j >> 6, qb = i5 < 256 ? (j & 63) : 127 - (j & 63);
        if (it < 512) attn_item<1>(P, shm, qb, g, dry); else attn_item<0>(P, shm, qb, g, dry);
    }
}


#define XB_TMO      128
#define XB_XCNT(j)  (256  + 64 * (j))
#define XB_XSUB(j)  (1280 + 64 * (j))
#define XB_XGEN(j)  (2304 + 64 * (j))
#define XB_TOP      3328
#define XB_TOPGEN   3392
#define XCD_BAR_WORDS 3456
#define XB_SPIN_CAP (1u << 18)

__device__ __forceinline__ unsigned xb_ld(unsigned* p)              { return __hip_atomic_load(p, __ATOMIC_RELAXED, __HIP_MEMORY_SCOPE_AGENT); }
__device__ __forceinline__ unsigned xb_add(unsigned* p, unsigned v) { return __hip_atomic_fetch_add(p, v, __ATOMIC_RELAXED, __HIP_MEMORY_SCOPE_AGENT); }
__device__ __forceinline__ unsigned xb_xcc_id() { return (unsigned)__builtin_amdgcn_s_getreg((3 << 11) | 20) & 0xFu; }
#define XB_SPIN(cond, bar) do { unsigned _sp = 0; while (cond) { __builtin_amdgcn_s_sleep(1); \
    if ((++_sp & 255u) == 0u) { if (xb_ld(&(bar)[XB_TMO])) break; if (_sp > XB_SPIN_CAP) { atomicAdd(&(bar)[XB_TMO], 1u); break; } } } } while (0)

struct XcdBarrier {
    unsigned* bar; unsigned x;
    volatile LAS unsigned* st;
};

__device__ __forceinline__ XcdBarrier xcd_barrier_post(unsigned* bar, volatile LAS unsigned* st) {
    XcdBarrier b; b.bar = bar; b.x = xb_xcc_id(); b.st = st;
    if (threadIdx.x == 0) (void)xb_add(&bar[XB_XCNT(b.x)], 1u);
    return b;
}
__device__ __forceinline__ void xcd_barrier_complete(unsigned* bar, unsigned x, unsigned& nloc, unsigned& nx) {
    const unsigned G = gridDim.x * gridDim.y * gridDim.z;
    unsigned sum, cnt, mine, sp = 0u;
    for (;;) {
        sum = 0u; cnt = 0u; mine = 0u;
#pragma unroll
        for (unsigned j = 0; j < 16; ++j) { const unsigned c = xb_ld(&bar[XB_XCNT(j)]); sum += c; cnt += (c > 0u) ? 1u : 0u; mine = (j == x) ? c : mine; }
        if (sum == G) break;
        __builtin_amdgcn_s_sleep(1);
        if ((++sp & 255u) == 0u) { if (xb_ld(&bar[XB_TMO])) break; if (sp > XB_SPIN_CAP) { atomicAdd(&bar[XB_TMO], 1u); break; } }
    }
    nloc = mine > 0u ? mine : 1u; nx = cnt > 0u ? cnt : 1u;
}

__device__ __forceinline__ void xcd_barrier(const XcdBarrier& b) {
    asm volatile("s_waitcnt vmcnt(0)" ::: "memory");
    __syncthreads();
    if (threadIdx.x == 0) {
        unsigned* bar = b.bar;
        __builtin_amdgcn_s_waitcnt(0);
        unsigned nloc = b.st[0], nx = b.st[1];
        if (nloc == 0u) { xcd_barrier_complete(bar, b.x, nloc, nx); b.st[0] = nloc; b.st[1] = nx; }
        const unsigned old = xb_add(&bar[XB_XSUB(b.x)], 1u);
        const unsigned gen = old / nloc;
        if (old + 1u == (gen + 1u) * nloc) {
            __builtin_amdgcn_fence(__ATOMIC_RELEASE, "agent");
            asm volatile("s_waitcnt vmcnt(0)" ::: "memory");
            const unsigned og = xb_add(&bar[XB_TOP], 1u);
            const unsigned tg = og / nx;
            if (og + 1u == (tg + 1u) * nx) xb_add(&bar[XB_TOPGEN], 1u);
            else XB_SPIN(xb_ld(&bar[XB_TOPGEN]) == tg, bar);
            __builtin_amdgcn_fence(__ATOMIC_ACQUIRE, "agent");
            xb_add(&bar[XB_XGEN(b.x)], 1u);
            asm volatile("s_waitcnt vmcnt(0)" ::: "memory");
        } else {
            XB_SPIN(xb_ld(&bar[XB_XGEN(b.x)]) == gen, bar);
            __builtin_amdgcn_fence(__ATOMIC_ACQUIRE, "agent");
            asm volatile("s_waitcnt vmcnt(0)" ::: "memory");
        }
    }
    __syncthreads();
}


constexpr int NPHASE = 12;
__global__ void __launch_bounds__(512, 2) hymba_mega(Params P) {
    extern __shared__ __attribute__((aligned(16))) unsigned char shm[];
    cg::grid_group grid = cg::this_grid();
    unsigned char* ws = P.ws;
    volatile LAS unsigned* xst = (volatile LAS unsigned*)(LAS unsigned char*)(shm + LDS_STAGE);
    if (threadIdx.x == 0) { xst[0] = 0u; xst[1] = 0u; }
    __syncthreads();
    const XcdBarrier xb = xcd_barrier_post((unsigned*)(ws + OFF_BAR), xst);
#define GSYNC(k) do { if ((k) == 0 && P.one == 0) grid.sync(); xcd_barrier(xb); } while (0)
#ifndef DUPMASK
#define DUPMASK 0
#endif
#define RUN_PHASE(k, ...) if (P.ph_lo <= (k) && (k) < P.ph_hi) { \
        if (DUPMASK & (1 << (k))) { const int dry = P.one; __VA_ARGS__ GSYNC(k); } \
        { const int dry = 0; (void)dry; __VA_ARGS__ } \
        if ((k) + 1 < P.ph_hi) GSYNC(k); }
#define GEMM_PHASE(EPI, Aoff, Boff, M_, N_, K_, ...) { pg8::Gemm g{(const bf16_t*)(ws + (Aoff)), (const bf16_t*)(ws + (Boff)), (M_), (N_), (K_), (K_)}; pg8::StaticOrder so; so.init((M_), (N_), (int)gridDim.x, (int)blockIdx.x); \
        EPI e{__VA_ARGS__}; pg8::gemm_phase<EPI, pg8::StaticOrder, false>((PG8_LAS unsigned char*)shm, g, so, e, nullptr); }
    RUN_PHASE(0, phase_prep(P, shm);)
    RUN_PHASE(1, GEMM_PHASE(EpiBf16Scale, OFF_XB, OFF_WIN, S_, 8192, DM, (bf16_t*)(ws + OFF_PROJ), NINP, (const float*)(ws + OFF_RSTD0), 0))
    RUN_PHASE(2, phase_norm(P, shm);)
    RUN_PHASE(3, phase3(P, shm, dry);)
    RUN_PHASE(4, phase_cmp2(P, shm);)
    RUN_PHASE(5, cmp_slc_phase(P, shm, dry);)
    RUN_PHASE(8, GEMM_PHASE(EpiOutProj, OFF_ON, OFF_WOUT, S_, DM, DM, P.x, P.out, (bf16_t*)(ws + OFF_X1B), (float*)(ws + OFF_SS1), dry, (const float*)(ws + OFF_SSAB)))
    RUN_PHASE(9, GEMM_PHASE(EpiGateUp, OFF_X1B, OFF_WGU, S_, NGU, DM, (bf16_t*)(ws + OFF_HF), (const float*)(ws + OFF_SS1), P.conv_w, P.conv_b, (float*)(ws + OFF_STL), (float*)(ws + OFF_STG), (float*)(ws + OFF_STU), (LAS float*)((PG8_LAS unsigned char*)shm + 131072)))
    RUN_PHASE(10, phase_fixup(P, -1, (int)(blockIdx.x * 512 + threadIdx.x), (int)(gridDim.x * 512));)
    RUN_PHASE(11, GEMM_PHASE(EpiDown, OFF_HF, OFF_WD, S_, DM, DFF, P.out, dry))
}

extern "C" void kernel_launch(void* const* d_in, const int* in_sizes, int n_in, void* d_out, int out_size, void* d_ws, size_t ws_size, hipStream_t stream) {
    static int grid_blocks = 0;
    if (grid_blocks == 0) {
        if (n_in != 22 || out_size != S_ * DM || ws_size < WS_END) { fprintf(stderr, "kernel_launch: unexpected shapes (n_in %d out %d ws %zu need %zu)\n", n_in, out_size, ws_size, (size_t)WS_END); grid_blocks = -1; return; }
        int dev = 0, cus = 0, per_cu = 0;
        hipGetDevice(&dev); hipDeviceGetAttribute(&cus, hipDeviceAttributeMultiprocessorCount, dev);
        if (hipFuncSetAttribute((const void*)hymba_mega, hipFuncAttributeMaxDynamicSharedMemorySize, LDS_BYTES) != hipSuccess) { fprintf(stderr, "kernel_launch: hipFuncSetAttribute failed\n"); grid_blocks = -1; return; }
        if (hipOccupancyMaxActiveBlocksPerMultiprocessor(&per_cu, (const void*)hymba_mega, 512, LDS_BYTES) != hipSuccess || per_cu < 1) { fprintf(stderr, "kernel_launch: occupancy query failed (%d)\n", per_cu); (void)hipGetLastError(); per_cu = 1; }
        grid_blocks = cus * per_cu;
        if (grid_blocks < 128) { fprintf(stderr, "kernel_launch: this kernel needs >= 128 co-resident workgroups (got %d)\n", grid_blocks); grid_blocks = -1; return; }
    }
    if (grid_blocks < 0) return;
    Params P{};
    const float** pp = (const float**)&P;
    for (int i = 0; i < 22; ++i) pp[i] = (const float*)d_in[i];
    P.out = (float*)d_out; P.ws = (unsigned char*)d_ws; P.ph_lo = 0; P.ph_hi = NPHASE; P.one = 1;
    if (hipMemsetAsync((unsigned char*)d_ws + OFF_BAR, 0, XCD_BAR_WORDS * sizeof(unsigned), stream) != hipSuccess) { fprintf(stderr, "kernel_launch: memset failed\n"); return; }
    void* args[] = {&P};
    hipError_t e = hipLaunchCooperativeKernel((const void*)hymba_mega, dim3(grid_blocks), dim3(512), args, LDS_BYTES, stream);
    if (e != hipSuccess) fprintf(stderr, "cooperative launch failed: %s (grid %d)\n", hipGetErrorString(e), grid_blocks);
}
```

```cpp
#include <hip/hip_runtime.h>
#include <hip/hip_cooperative_groups.h>
#include <cstdio>
#include <cstdint>
namespace cg = cooperative_groups;
#include <type_traits>
namespace pg8 {
#define PG8_LAS __attribute__((address_space(3)))
typedef unsigned short bf16_t;
typedef short bf16x8 __attribute__((ext_vector_type(8)));
typedef float f32x4 __attribute__((ext_vector_type(4)));
typedef unsigned u32x4 __attribute__((ext_vector_type(4)));
constexpr int BM = 256, BK = 64, HALF = 128, HTB = HALF * BK * 2  , STAGE_BYTES = 8 * HTB, NXCD = 8, WGM = 8;

__host__ __device__ __forceinline__ int lds_byte(int r, int c) { const int st = (r >> 4) * 2 + (c >> 5), rr = r & 15, cc = c & 31, ob = rr * 64 + cc * 2; return st * 1024 + (ob ^ (((ob >> 9) & 1) << 5)); }
__host__ __device__ __forceinline__ void stage_rc(int b, int& R, int& C) { const int st = b / 1024, sb = b % 1024, swz = sb ^ (((sb >> 9) & 1) << 5); R = (st >> 1) * 16 + swz / 64; C = (st & 1) * 32 + (swz % 64) / 2; }
__host__ __device__ __forceinline__ int perm32(int rho) { const int n = rho >> 4, i = rho & 15; return 8 * (i >> 2) + 4 * n + (i & 3); }

struct Unit { int pm, pn; };
struct Gemm { const bf16_t* A; const bf16_t* Bt; int M, N, K, ld; };

struct StaticOrder {
    int nM, nN, nwg, G, c;
    __host__ __device__ void init(int M, int N, int G_, int c_) { nM = M / BM; nN = N / BM; nwg = nM * nN; G = G_; c = c_; }
    __host__ __device__ bool next(int i, Unit& u) const {
        const long L = (long)i * G + c; if (L >= nwg) return false;
        int wgid = (int)L; { const int q = nwg / NXCD, r = nwg % NXCD, xcd = wgid % NXCD, off = wgid / NXCD; wgid = (xcd < r ? xcd * (q + 1) : r * (q + 1) + (xcd - r) * q) + off; }
        const int nig = WGM * nN, gid = wgid / nig, fm = gid * WGM, gsz = (nM - fm) < WGM ? (nM - fm) : WGM;
        u.pm = fm + ((wgid % nig) % gsz); u.pn = (wgid % nig) / gsz; return true;
    }
    __device__ __forceinline__ void a_ready(const Unit&) const {}
    __device__ __forceinline__ void done(const Unit&) const {}
};
__device__ __forceinline__ unsigned cvt_pk_bf16(float lo, float hi) { unsigned r; asm volatile("v_cvt_pk_bf16_f32 %0, %1, %2" : "=v"(r) : "v"(lo), "v"(hi)); return r; }
template <class Epi, class Sched, bool STAMP = false>
__device__ __forceinline__ void gemm_phase(PG8_LAS unsigned char* lds, const Gemm g, const Sched& S, const Epi& E, unsigned long long* stamps) {
    const int tid = threadIdx.x, wid = __builtin_amdgcn_readfirstlane(tid >> 6), lane = tid & 63, wr = wid >> 2, wc = wid & 3, fr = lane & 15, fq = lane >> 4;
    const int K = g.ld, nt = g.K / BK;
    int ts_lo = 0, ts_hi = 0, nts = 0; const unsigned long long rt_entry = STAMP ? (unsigned long long)wall_clock64() : 0ull;
#define PG8_STAMP() do { if (STAMP && wid == 0 && nts < 64) { const unsigned long long _c = (unsigned long long)clock64(); \
        ts_lo = (lane == nts) ? (int)(unsigned)_c : ts_lo; ts_hi = (lane == nts) ? (int)(unsigned)(_c >> 32) : ts_hi; ++nts; } } while (0)
    PG8_STAMP();
    unsigned voffA[2], voffB[2];
#pragma unroll
    for (int i = 0; i < 2; ++i) { int R, C; stage_rc(tid * 16 + i * 8192, R, C); const int Rb = Epi::PERM ? ((R & ~31) + perm32(R & 31)) : R;
        voffA[i] = (unsigned)(R * K + C) * 2u; voffB[i] = (unsigned)(Rb * K + C) * 2u; }
    const size_t kstep = (size_t)(BK * 2);
    const size_t hstep = (size_t)HALF * K * 2;
    const size_t tstep = 2 * hstep;
    const unsigned ldsw = (unsigned)wid * 1024u;
    const int aoff = lds_byte(wr * 64 + fr, fq * 8), boff = lds_byte(wc * 32 + fr, fq * 8);
#define PG8_SA(b, h) (((b) * 2 + (h)) * HTB)
#define PG8_SB(b, h) ((4 + (b) * 2 + (h)) * HTB)
#define PG8_STAGE(bufoff, gbase, voff) do { _Pragma("unroll") for (int _i = 0; _i < 2; ++_i) \
        __builtin_amdgcn_global_load_lds((const unsigned*)((const char*)(gbase) + (voff)[_i]), (PG8_LAS unsigned*)(lds + (bufoff) + ldsw + _i * 8192), 16, 0, 0); } while (0)
#define PG8_LDA(dst, b, h) do { _Pragma("unroll") for (int m = 0; m < 4; ++m) _Pragma("unroll") for (int k = 0; k < 2; ++k) dst[m][k] = *(const PG8_LAS bf16x8*)(lds + PG8_SA(b, h) + aoff + m * 2048 + k * 1024); } while (0)
#define PG8_LDB(dst, b, h) do { _Pragma("unroll") for (int n = 0; n < 2; ++n) _Pragma("unroll") for (int k = 0; k < 2; ++k) dst[n][k] = *(const PG8_LAS bf16x8*)(lds + PG8_SB(b, h) + boff + n * 2048 + k * 1024); } while (0)
#define PG8_MMA(ai, bj, At, Bt) do { __builtin_amdgcn_s_setprio(1); _Pragma("unroll") for (int m = 0; m < 4; ++m) _Pragma("unroll") for (int n = 0; n < 2; ++n) _Pragma("unroll") for (int k = 0; k < 2; ++k) \
        acc[ai][bj][m][n] = __builtin_amdgcn_mfma_f32_16x16x32_bf16(Bt[n][k], At[m][k], acc[ai][bj][m][n], 0, 0, 0); __builtin_amdgcn_s_setprio(0); } while (0)
#define PG8_WAIT_V(n) asm volatile("s_waitcnt vmcnt(" #n ")" ::: "memory")
#define PG8_WAIT_L(n) asm volatile("s_waitcnt lgkmcnt(" #n ")" ::: "memory")
#define PG8_BAR __builtin_amdgcn_s_barrier()
#define PG8_SCHED __builtin_amdgcn_sched_barrier(0)
    Unit cur, nxt; int ui = 0;
    if (!S.next(0, cur)) return;
    f32x4 acc[2][2][4][2];
#pragma unroll
    for (int a = 0; a < 2; ++a)
#pragma unroll
        for (int b = 0; b < 2; ++b)
#pragma unroll
            for (int m = 0; m < 4; ++m)
#pragma unroll
                for (int n = 0; n < 2; ++n) acc[a][b][m][n] = (f32x4){0.f, 0.f, 0.f, 0.f};
    bf16x8 At[4][2], B0[2][2], B1[2][2];
    const char* cA = (const char*)g.A + (size_t)cur.pm * tstep; const char* cB = (const char*)g.Bt + (size_t)cur.pn * tstep;
    S.a_ready(cur);
    PG8_STAGE(PG8_SB(0, 0), cB, voffB); PG8_STAGE(PG8_SA(0, 0), cA, voffA); PG8_STAGE(PG8_SB(0, 1), cB + hstep, voffB); PG8_STAGE(PG8_SA(0, 1), cA + hstep, voffA);
    if (wr == 1) PG8_BAR;
    PG8_WAIT_V(4); PG8_BAR;
    PG8_STAGE(PG8_SB(1, 0), cB + kstep, voffB); PG8_STAGE(PG8_SA(1, 0), cA + kstep, voffA); PG8_STAGE(PG8_SB(1, 1), cB + hstep + kstep, voffB);
    PG8_WAIT_V(6); PG8_BAR;
    PG8_STAMP();
    for (;;) {
        const bool has_next = S.next(ui + 1, nxt);
        const char* nA = has_next ? (const char*)g.A + (size_t)nxt.pm * tstep : cA; const char* nB = has_next ? (const char*)g.Bt + (size_t)nxt.pn * tstep : cB;
        for (int t = 0; t < nt; t += 2) {
            const bool last = (t == nt - 2);
            if constexpr (Epi::MIDSCALE) { if (t == (nt >> 1)) E.mid(acc, cur, wr, wc, fr, fq); }
            const char* a1 = cA + (size_t)(t + 1) * kstep;
            const char* a2 = last ? nA : cA + (size_t)(t + 2) * kstep; const char* b2 = last ? nB : cB + (size_t)(t + 2) * kstep;
            const char* a3 = a2 + kstep; const char* b3 = b2 + kstep;
            if (last && has_next) S.a_ready(nxt);
            PG8_LDB(B0, 0, 0); PG8_SCHED; PG8_LDA(At, 0, 0); PG8_STAGE(PG8_SA(1, 1), a1 + hstep, voffA);
            PG8_WAIT_L(8); PG8_BAR; PG8_WAIT_L(0); PG8_MMA(0, 0, At, B0); PG8_BAR; PG8_SCHED;
            PG8_LDB(B1, 0, 1); PG8_STAGE(PG8_SB(0, 0), b2, voffB);
            PG8_BAR; PG8_WAIT_L(0); PG8_MMA(0, 1, At, B1); PG8_BAR;
            PG8_LDA(At, 0, 1); PG8_STAGE(PG8_SA(0, 0), a2, voffA);
            PG8_BAR; PG8_WAIT_L(0); PG8_MMA(1, 0, At, B0); PG8_BAR; PG8_SCHED;
            PG8_STAGE(PG8_SB(0, 1), b2 + hstep, voffB);
            PG8_WAIT_V(6); PG8_BAR; PG8_MMA(1, 1, At, B1); PG8_BAR;
            PG8_LDB(B0, 1, 0); PG8_SCHED; PG8_LDA(At, 1, 0); PG8_STAGE(PG8_SA(0, 1), a2 + hstep, voffA);
            PG8_WAIT_L(8); PG8_BAR; PG8_WAIT_L(0); PG8_MMA(0, 0, At, B0); PG8_BAR; PG8_SCHED;
            PG8_LDB(B1, 1, 1); PG8_STAGE(PG8_SB(1, 0), b3, voffB);
            PG8_BAR; PG8_WAIT_L(0); PG8_MMA(0, 1, At, B1); PG8_BAR;
            PG8_LDA(At, 1, 1); PG8_STAGE(PG8_SA(1, 0), a3, voffA);
            PG8_BAR; PG8_WAIT_L(0); PG8_MMA(1, 0, At, B0); PG8_BAR; PG8_SCHED;
            PG8_STAGE(PG8_SB(1, 1), b3 + hstep, voffB);
            PG8_WAIT_V(6); PG8_BAR; PG8_MMA(1, 1, At, B1); PG8_BAR;
        }
        PG8_STAMP();
        if constexpr (!Epi::AFTER_DRAIN) { E(acc, cur, wr, wc, fr, fq); S.done(cur); }
        PG8_STAMP();
        if (!has_next) break;
#pragma unroll
        for (int a = 0; a < 2; ++a)
#pragma unroll
            for (int b = 0; b < 2; ++b)
#pragma unroll
                for (int m = 0; m < 4; ++m)
#pragma unroll
                    for (int n = 0; n < 2; ++n) acc[a][b][m][n] = (f32x4){0.f, 0.f, 0.f, 0.f};
        cur = nxt; cA = nA; cB = nB; ++ui;
    }
    PG8_WAIT_V(0);
    if (wr == 0) PG8_BAR;
    PG8_BAR;
    if constexpr (Epi::AFTER_DRAIN) { E.fused(acc, cur, wr, wc, fr, fq, lds, wid, lane); S.done(cur); }
    PG8_STAMP();
    if (STAMP && wid == 0) { stamps[lane] = lane < nts ? (((unsigned long long)(unsigned)ts_hi << 32) | (unsigned)ts_lo) : 0ull;
        if (lane == 62) stamps[62] = rt_entry; if (lane == 63) stamps[63] = (unsigned long long)wall_clock64(); }
#undef PG8_STAMP
#undef PG8_SA
#undef PG8_SB
#undef PG8_STAGE
#undef PG8_LDA
#undef PG8_LDB
#undef PG8_MMA
#undef PG8_WAIT_V
#undef PG8_WAIT_L
#undef PG8_BAR
#undef PG8_SCHED
}
}

#define LAS __attribute__((address_space(3)))
typedef unsigned short bf16_t;
typedef short bf16x8 __attribute__((ext_vector_type(8)));
typedef float f32x4 __attribute__((ext_vector_type(4)));
typedef unsigned u32x4 __attribute__((ext_vector_type(4)));
typedef unsigned u32x2 __attribute__((ext_vector_type(2)));
using pg8::cvt_pk_bf16;

constexpr int S_ = 8192, DM = 4096, NIN = 8240, NINP = 8448, DFF = 11008, NGU = 22016;
constexpr float EPS_ = 1e-6f;
constexpr float LOG2E = 1.4426950408889634f;
constexpr float QSCALE = 0.08838834764831845f * 1.4426950408889634f;
constexpr int LDS_STAGE = 147456, LDS_BYTES = LDS_STAGE + 256;

constexpr size_t SZ_WGU = (size_t)NGU * DM * 2, SZ_WD = (size_t)DM * DFF * 2, SZ_WOUT = (size_t)DM * DM * 2, SZ_W1 = 512ull * 4096 * 2, SZ_SMALL = 1u << 20;
constexpr size_t OFF_WGU = 0, OFF_WD = OFF_WGU + SZ_WGU, OFF_WOUT = OFF_WD + SZ_WD, OFF_W1 = OFF_WOUT + SZ_WOUT, OFF_SMALL = OFF_W1 + SZ_W1;
constexpr size_t OFF_BAR = OFF_SMALL + 262144;
constexpr size_t OFF_SSAB = OFF_SMALL + 327680;
constexpr size_t OFF_MREF = OFF_SMALL + 197632;
constexpr size_t OFF_QCTR = OFF_SMALL + 196608;
constexpr size_t OFF_RSTD0 = OFF_SMALL, OFF_SS1 = OFF_SMALL + 32768, OFF_B1PART = OFF_SMALL + 65536, OFF_B1P = OFF_SMALL + 131072;
constexpr size_t OFF_C = OFF_SMALL + SZ_SMALL;
constexpr size_t SZ_Q = (size_t)S_ * 2048 * 2, SZ_KV = (size_t)S_ * 512 * 2;
constexpr size_t OFF_QA = OFF_C, OFF_QB = OFF_QA + SZ_Q, OFF_KA = OFF_QB + SZ_Q, OFF_KS = OFF_KA + SZ_KV, OFF_KW = OFF_KS + SZ_KV;
constexpr size_t OFF_VA = OFF_KW + SZ_KV, OFF_VS = OFF_VA + SZ_KV, OFF_VW = OFF_VS + SZ_KV;
constexpr size_t OFF_GATES = OFF_VW + SZ_KV, SZ_GATES = (size_t)S_ * 48 * 4;
constexpr size_t OFF_IM2 = OFF_GATES + SZ_GATES, SZ_IM2 = 4096ull * 4096 * 2;
constexpr size_t OFF_H = OFF_IM2 + SZ_IM2, SZ_H = 4096ull * 256 * 2;
constexpr size_t OFF_KC = OFF_H + SZ_H, SZ_KC = 4ull * 512 * 128 * 2;
constexpr size_t OFF_VCT = OFF_KC + SZ_KC;
constexpr size_t OFF_SEL = OFF_VCT + SZ_KC, SZ_SEL = 4ull * S_ * 16;
constexpr size_t OFF_B = OFF_SEL + SZ_SEL;
constexpr size_t SZ_WIN = (size_t)NINP * DM * 2, SZ_XB = (size_t)S_ * DM * 2, SZ_PROJ = (size_t)S_ * NINP * 2;
constexpr size_t OFF_WIN = OFF_B, OFF_XB = OFF_WIN + SZ_WIN, OFF_PROJ = OFF_XB + SZ_XB;
constexpr size_t OFF_HACC = OFF_PROJ + SZ_PROJ, SZ_HACC = 4096ull * 256 * 4;
constexpr size_t OFF_GACC = OFF_HACC + SZ_HACC, SZ_GACC = (size_t)S_ * 48 * 4;
constexpr size_t WS_END = OFF_GACC + SZ_GACC;
constexpr size_t OFF_GU = OFF_C, SZ_GU = (size_t)S_ * NGU * 2;
constexpr size_t OFF_X1B = OFF_PROJ + SZ_PROJ - SZ_XB;
constexpr size_t OFF_ON = OFF_WIN;
constexpr size_t SZ_STASH = 32ull * 2 * DFF * 4;
constexpr size_t OFF_STL = OFF_C, OFF_STG = OFF_STL + SZ_STASH, OFF_STU = OFF_STG + SZ_STASH;
constexpr size_t OFF_HF = OFF_C + (16u << 20);
static_assert(OFF_STU + SZ_STASH <= OFF_HF && OFF_HF + (size_t)S_ * DFF * 2 <= OFF_X1B, "h / stash placement");
static_assert(OFF_X1B >= OFF_GU + SZ_GU, "x1b overlaps GU");
static_assert(SZ_XB <= SZ_WIN, "o_n overlay");

struct Params {
    const float *x, *rel_bias, *norm_mix_g, *w_in, *a_q_g, *a_k_g, *a_sinks, *b_q_g, *b_k_g, *pos_emb, *cmp_w1, *cmp_b1, *cmp_w2, *cmp_b2,
        *out_norm_g, *w_out, *norm_ffn_g, *w_gate, *w_up, *conv_w, *conv_b, *w_down;
    float* out;
    unsigned char* ws;
    int ph_lo, ph_hi, one, pad_;
};

__device__ __forceinline__ float bf_lo(unsigned w) { return __uint_as_float(w << 16); }
__device__ __forceinline__ float bf_hi(unsigned w) { return __uint_as_float(w & 0xffff0000u); }
__device__ __forceinline__ float wave_sum(float v) {
#pragma unroll
    for (int o = 32; o >= 1; o >>= 1) v += __shfl_xor(v, o);
    return v;
}
__constant__ unsigned char T5B[132] = {0, 1, 2, 3, 4, 5, 6, 7, 8, 9, 10, 11, 12, 13, 14, 15, 16, 16, 16, 17, 17, 18, 18, 18, 19, 19, 19, 20, 20, 20, 20, 21, 21, 21, 21, 22, 22, 22, 22, 22, 23, 23, 23, 23, 23, 23, 24, 24, 24, 24, 24, 24, 25, 25, 25, 25, 25, 25, 25, 26, 26, 26, 26, 26, 26, 26, 26, 27, 27, 27, 27, 27, 27, 27, 27, 27, 27, 28, 28, 28, 28, 28, 28, 28, 28, 28, 28, 29, 29, 29, 29, 29, 29, 29, 29, 29, 29, 29, 29, 30, 30, 30, 30, 30, 30, 30, 30, 30, 30, 30, 30, 30, 30, 31, 31, 31, 31, 31, 31, 31, 31, 31, 31, 31, 31, 31, 31, 31, 31, 31, 31, 31};

struct EpiBf16Scale {
    static constexpr bool PERM = true, AFTER_DRAIN = false, MIDSCALE = false;
    bf16_t* O; int ldc; const float* rs; int mode;
    __device__ __forceinline__ void operator()(const f32x4 (&acc)[2][2][4][2], const pg8::Unit& u, int wr, int wc, int fr, int fq) const {
        const int row0 = u.pm * 256 + wr * 64 + fr, col0 = u.pn * 256 + wc * 32 + 8 * fq;
#pragma unroll
        for (int ai = 0; ai < 2; ++ai)
#pragma unroll
            for (int m = 0; m < 4; ++m) {
                const int row = row0 + ai * 128 + m * 16;
                float sc = rs[row]; if (mode) sc = rsqrtf(sc * (1.0f / 4096.0f) + EPS_);
                bf16_t* rowp = O + (size_t)row * ldc + col0;
#pragma unroll
                for (int bj = 0; bj < 2; ++bj) { const f32x4 v0 = acc[ai][bj][m][0] * sc, v1 = acc[ai][bj][m][1] * sc;
                    u32x4 w; w.x = cvt_pk_bf16(v0[0], v0[1]); w.y = cvt_pk_bf16(v0[2], v0[3]); w.z = cvt_pk_bf16(v1[0], v1[1]); w.w = cvt_pk_bf16(v1[2], v1[3]);
                    *(u32x4*)(rowp + bj * 128) = w; }
            }
    }
};
struct EpiCmp {
    static constexpr bool PERM = false, AFTER_DRAIN = false, MIDSCALE = false;
    float* Hacc;
    __device__ __forceinline__ void operator()(const f32x4 (&acc)[2][2][4][2], const pg8::Unit& u, int wr, int wc, int fr, int fq) const {
        if ((u.pm >> 3) != u.pn) return;
        const int row0 = u.pm * 256 + wr * 64 + fr, col0 = wc * 32 + 4 * fq;
#pragma unroll
        for (int ai = 0; ai < 2; ++ai)
#pragma unroll
            for (int m = 0; m < 4; ++m) { float* rp = Hacc + (size_t)(row0 + ai * 128 + m * 16) * 256 + col0;
#pragma unroll
                for (int bj = 0; bj < 2; ++bj)
#pragma unroll
                    for (int n = 0; n < 2; ++n)
#pragma unroll
                        for (int j = 0; j < 4; ++j) atomicAdd(rp + bj * 128 + n * 16 + j, acc[ai][bj][m][n][j]); }
    }
};
struct EpiGates {
    static constexpr bool PERM = false, AFTER_DRAIN = false, MIDSCALE = false;
    float* gacc; const float* rstd;
    __device__ __forceinline__ void operator()(const f32x4 (&acc)[2][2][4][2], const pg8::Unit& u, int wr, int wc, int fr, int fq) const {
        if (wc > 1) return;
        const int row0 = u.pm * 256 + wr * 64 + fr;
#pragma unroll
        for (int ai = 0; ai < 2; ++ai)
#pragma unroll
            for (int m = 0; m < 4; ++m) {
                const int row = row0 + ai * 128 + m * 16; const float sc = rstd[row];
#pragma unroll
                for (int n = 0; n < 2; ++n) { const int col = wc * 32 + n * 16 + 4 * fq;
                    if (col < 48) {
#pragma unroll
                        for (int j = 0; j < 4; ++j) atomicAdd(gacc + (size_t)row * 48 + col + j, acc[ai][0][m][n][j] * sc); } }
            }
    }
};
struct EpiGateUp {
    static constexpr bool PERM = true, AFTER_DRAIN = false, MIDSCALE = false;
    bf16_t* hf; const float* ss1; const float* conv_w; const float* conv_b; float* stL; float* stG; float* stU; LAS float* X;
    __device__ __forceinline__ void operator()(const f32x4 (&acc)[2][2][4][2], const pg8::Unit& u, int wr, int wc, int fr, int fq) const {
        const int rowb = u.pm * 256 + wr * 64 + fr, colL = wc * 32 + 8 * fq, colG = u.pn * 128 + colL;
        float sc[2][4];
#pragma unroll
        for (int ai = 0; ai < 2; ++ai)
#pragma unroll
            for (int m = 0; m < 4; ++m) sc[ai][m] = rsqrtf(ss1[rowb + ai * 128 + m * 16] * (1.0f / 4096.0f) + EPS_);
        if (fr >= 14) {
#pragma unroll
            for (int ai = 0; ai < 2; ++ai)
#pragma unroll
                for (int n = 0; n < 2; ++n) { const f32x4 g = acc[ai][0][3][n] * sc[ai][3];
                    *(LAS f32x4*)(X + (((ai * 2 + wr) * 2 + (fr - 14)) * 128) + colL + 4 * n) = g;
                    if (ai == 1 && wr == 1) *(f32x4*)(stL + ((size_t)u.pm * 2 + (fr - 14)) * DFF + colG + 4 * n) = g; }
        }
        if (fr < 2 && wr == 0) {
#pragma unroll
            for (int n = 0; n < 2; ++n) { *(f32x4*)(stG + ((size_t)u.pm * 2 + fr) * DFF + colG + 4 * n) = acc[0][0][0][n] * sc[0][0];
                                          *(f32x4*)(stU + ((size_t)u.pm * 2 + fr) * DFF + colG + 4 * n) = acc[0][1][0][n] * sc[0][0]; }
        }
        f32x4 cw0[2], cw1[2], cw2[2], ccb[2];
#pragma unroll
        for (int n = 0; n < 2; ++n) { cw0[n] = *(const f32x4*)(conv_w + colG + 4 * n); cw1[n] = *(const f32x4*)(conv_w + DFF + colG + 4 * n); cw2[n] = *(const f32x4*)(conv_w + 2 * DFF + colG + 4 * n); ccb[n] = *(const f32x4*)(conv_b + colG + 4 * n); }
        asm volatile("s_waitcnt lgkmcnt(0)" ::: "memory"); __builtin_amdgcn_s_barrier(); __builtin_amdgcn_s_barrier(); asm volatile("" ::: "memory");
#pragma unroll
        for (int ai = 0; ai < 2; ++ai) {
            const bool havepred = (wr == 1) || (ai == 1);
            const int pblk = (wr == 1) ? ai * 2 : 1;
            u32x2 hp[4][2];
#pragma unroll
            for (int n = 0; n < 2; ++n) {
                const f32x4 w0 = cw0[n], w1 = cw1[n], w2 = cw2[n], cb = ccb[n];
                f32x4 B62 = {0.f, 0.f, 0.f, 0.f}, B63 = {0.f, 0.f, 0.f, 0.f};
                if (havepred) { B62 = *(const LAS f32x4*)(X + (pblk * 2 + 0) * 128 + colL + 4 * n); B63 = *(const LAS f32x4*)(X + (pblk * 2 + 1) * 128 + colL + 4 * n); }
                f32x4 g[4], s1[4], s2[4];
#pragma unroll
                for (int m = 0; m < 4; ++m) g[m] = acc[ai][0][m][n] * sc[ai][m];
#pragma unroll
                for (int m = 0; m < 4; ++m)
#pragma unroll
                    for (int j = 0; j < 4; ++j) { const int gi = __float_as_int(g[m][j]); s1[m][j] = __int_as_float(__builtin_amdgcn_mov_dpp(gi, 0x121, 0xf, 0xf, false)); s2[m][j] = __int_as_float(__builtin_amdgcn_mov_dpp(gi, 0x122, 0xf, 0xf, false)); }
#pragma unroll
                for (int m = 0; m < 4; ++m) {
                    const f32x4 p1 = (fr >= 1) ? s1[m] : (m > 0 ? s1[m > 0 ? m - 1 : 0] : B63);
                    const f32x4 p2 = (fr >= 2) ? s2[m] : (m > 0 ? s2[m > 0 ? m - 1 : 0] : (fr == 1 ? B63 : B62));
                    const f32x4 uu = acc[ai][1][m][n] * sc[ai][m];
                    const f32x4 z = cb + w0 * p2 + w1 * p1 + w2 * g[m];
                    f32x4 hv;
#pragma unroll
                    for (int j = 0; j < 4; ++j) hv[j] = z[j] * __builtin_amdgcn_rcpf(1.0f + __expf(-z[j])) * uu[j];
                    hp[m][n].x = cvt_pk_bf16(hv[0], hv[1]); hp[m][n].y = cvt_pk_bf16(hv[2], hv[3]);
                }
            }
#pragma unroll
            for (int m = 0; m < 4; ++m) {
                const bool skip = (ai == 0) && (wr == 0) && (m == 0) && (fr < 2);
                if (!skip) { u32x4 w; w.x = hp[m][0].x; w.y = hp[m][0].y; w.z = hp[m][1].x; w.w = hp[m][1].y;
                    *(u32x4*)(hf + (size_t)(rowb + ai * 128 + m * 16) * DFF + colG) = w; }
            }
        }
    }
};
struct EpiOutProj {
    static constexpr bool PERM = false, AFTER_DRAIN = false, MIDSCALE = true;
    const float* x; float* out; bf16_t* x1b; float* ss1; int dry; const float* ssAB;
    __device__ __forceinline__ void mid(f32x4 (&acc)[2][2][4][2], const pg8::Unit& u, int wr, int wc, int fr, int fq) const {
        const int row0 = u.pm * 256 + wr * 64 + fr;
#pragma unroll
        for (int ai = 0; ai < 2; ++ai) {
            float2 s[4];
#pragma unroll
            for (int m = 0; m < 4; ++m) s[m] = *(const float2*)(ssAB + 2 * (row0 + ai * 128 + m * 16));
#pragma unroll
            for (int m = 0; m < 4; ++m) {
                const float r = rsqrtf(s[m].x * (1.0f / 2048.0f) + EPS_) * sqrtf(s[m].y * (1.0f / 2048.0f) + EPS_);
#pragma unroll
                for (int bj = 0; bj < 2; ++bj)
#pragma unroll
                    for (int n = 0; n < 2; ++n) acc[ai][bj][m][n] = acc[ai][bj][m][n] * r; }
            asm volatile("" ::: "memory");
        }
    }
    __device__ __forceinline__ void operator()(const f32x4 (&acc)[2][2][4][2], const pg8::Unit& u, int wr, int wc, int fr, int fq) const {
        if (dry) return;
        const int row0 = u.pm * 256 + wr * 64 + fr, col0 = u.pn * 256 + wc * 32 + 4 * fq;
#pragma unroll
        for (int ai = 0; ai < 2; ++ai)
#pragma unroll
            for (int mp = 0; mp < 4; mp += 2) {
                f32x4 xv[2][2][2]; float rB[2];
#pragma unroll
                for (int mm = 0; mm < 2; ++mm) { const int row = row0 + ai * 128 + (mp + mm) * 16; const size_t off = (size_t)row * DM + col0;
                    rB[mm] = ssAB[2 * row + 1];
#pragma unroll
                    for (int bj = 0; bj < 2; ++bj)
#pragma unroll
                        for (int n = 0; n < 2; ++n) xv[mm][bj][n] = *(const f32x4*)(x + off + bj * 128 + n * 16); }
#pragma unroll
                for (int mm = 0; mm < 2; ++mm) { const int m = mp + mm; const int row = row0 + ai * 128 + m * 16; const size_t off = (size_t)row * DM + col0; float ss = 0.f;
                    const float rb = rsqrtf(rB[mm] * (1.0f / 2048.0f) + EPS_);
#pragma unroll
                    for (int bj = 0; bj < 2; ++bj)
#pragma unroll
                        for (int n = 0; n < 2; ++n) { const f32x4 o = xv[mm][bj][n] + acc[ai][bj][m][n] * rb;
                            *(f32x4*)(out + off + bj * 128 + n * 16) = o;
                            u32x2 w; w.x = cvt_pk_bf16(o[0], o[1]); w.y = cvt_pk_bf16(o[2], o[3]); *(u32x2*)(x1b + off + bj * 128 + n * 16) = w;
                            ss += (o[0] * o[0] + o[1] * o[1]) + (o[2] * o[2] + o[3] * o[3]); }
                    ss += __shfl_xor(ss, 16); ss += __shfl_xor(ss, 32);
                    if (fq == 0) atomicAdd(ss1 + row, ss); }
            }
    }
};
struct EpiDown {
    static constexpr bool PERM = false, AFTER_DRAIN = false, MIDSCALE = false;
    float* out; int dry;
    __device__ __forceinline__ void operator()(const f32x4 (&acc)[2][2][4][2], const pg8::Unit& u, int wr, int wc, int fr, int fq) const {
        if (dry) return;
        const int row0 = u.pm * 256 + wr * 64 + fr, col0 = u.pn * 256 + wc * 32 + 4 * fq;
#pragma unroll
        for (int ai = 0; ai < 2; ++ai)
#pragma unroll
            for (int mp = 0; mp < 4; mp += 2) {
                f32x4 ov[2][2][2];
#pragma unroll
                for (int mm = 0; mm < 2; ++mm)
#pragma unroll
                    for (int bj = 0; bj < 2; ++bj)
#pragma unroll
                        for (int n = 0; n < 2; ++n) ov[mm][bj][n] = *(const f32x4*)(out + (size_t)(row0 + ai * 128 + (mp + mm) * 16) * DM + col0 + bj * 128 + n * 16);
#pragma unroll
                for (int mm = 0; mm < 2; ++mm)
#pragma unroll
                    for (int bj = 0; bj < 2; ++bj)
#pragma unroll
                        for (int n = 0; n < 2; ++n) *(f32x4*)(out + (size_t)(row0 + ai * 128 + (mp + mm) * 16) * DM + col0 + bj * 128 + n * 16) = ov[mm][bj][n] + acc[ai][bj][mp + mm][n];
            }
    }
};

struct TDesc { const float* src; const float* gain; bf16_t* dst; int K, N, kt, nt, drow0; };
struct TRegs { f32x4 a[2], b[2]; float ga[2], gb[2]; };
__device__ __forceinline__ void tconv_load(const TDesc& t, TRegs& r) {
    const int tid = threadIdx.x, n4 = (tid & 31) * 4, kp = tid >> 5, k0 = t.kt * 64, n0 = t.nt * 128;
#pragma unroll
    for (int i = 0; i < 2; ++i) {
        const int kk = 2 * (kp + 16 * i);
        r.a[i] = (f32x4){0.f, 0.f, 0.f, 0.f}; r.b[i] = (f32x4){0.f, 0.f, 0.f, 0.f};
        if (n0 + n4 < t.N) { r.a[i] = __builtin_nontemporal_load((const f32x4*)(t.src + (size_t)(k0 + kk) * t.N + n0 + n4)); r.b[i] = __builtin_nontemporal_load((const f32x4*)(t.src + (size_t)(k0 + kk + 1) * t.N + n0 + n4)); }
        r.ga[i] = t.gain ? t.gain[k0 + kk] : 1.0f; r.gb[i] = t.gain ? t.gain[k0 + kk + 1] : 1.0f;
    }
}
__device__ __forceinline__ void tconv_store(unsigned* ldsw, const TDesc& t, const TRegs& r) {
    const int tid = threadIdx.x, n4 = (tid & 31) * 4, kp = tid >> 5, k0 = t.kt * 64, n0 = t.nt * 128;
#pragma unroll
    for (int i = 0; i < 2; ++i) {
        const f32x4 a = r.a[i] * r.ga[i], b = r.b[i] * r.gb[i];
#pragma unroll
        for (int j = 0; j < 4; ++j) ldsw[(n4 + j) * 33 + kp + 16 * i] = cvt_pk_bf16(a[j], b[j]);
    }
    __syncthreads();
    const int n = tid >> 2, c = tid & 3;
    u32x4 w0, w1;
    w0.x = ldsw[n * 33 + c * 8 + 0]; w0.y = ldsw[n * 33 + c * 8 + 1]; w0.z = ldsw[n * 33 + c * 8 + 2]; w0.w = ldsw[n * 33 + c * 8 + 3];
    w1.x = ldsw[n * 33 + c * 8 + 4]; w1.y = ldsw[n * 33 + c * 8 + 5]; w1.z = ldsw[n * 33 + c * 8 + 6]; w1.w = ldsw[n * 33 + c * 8 + 7];
    bf16_t* dp = t.dst + (size_t)(t.drow0 + n) * t.K + k0 + c * 16;
    *(u32x4*)dp = w0; *(u32x4*)(dp + 8) = w1;
    __syncthreads();
}

__device__ void phase_prep(const Params& P, unsigned char* shm) {
    unsigned* ldsw = (unsigned*)shm;
    unsigned char* ws = P.ws;
    const int tid = threadIdx.x, wid = tid >> 6, lane = tid & 63;
    if (blockIdx.x == 0 && tid == 0) *(unsigned*)(ws + OFF_QCTR) = 0u;
    for (size_t i = (size_t)blockIdx.x * 512 + tid; i < (SZ_HACC + SZ_GACC) / 16; i += (size_t)gridDim.x * 512) ((f32x4*)(ws + OFF_HACC))[i] = (f32x4){0.f, 0.f, 0.f, 0.f};
    if (blockIdx.x == 0 && wid == 1) {
        float aq = fmaxf(fabsf(P.a_q_g[lane]), fabsf(P.a_q_g[lane + 64])), ak = fmaxf(fabsf(P.a_k_g[lane]), fabsf(P.a_k_g[lane + 64]));
        float bq = fmaxf(fabsf(P.b_q_g[lane]), fabsf(P.b_q_g[lane + 64])), bk = 0.f, ta = 0.f, tb = 0.f;
        for (int i = lane; i < 384; i += 64) bk = fmaxf(bk, fabsf(P.b_k_g[i]));
        for (int i = lane; i < 1024; i += 64) { const float v = fabsf(P.rel_bias[i]); if ((i & 31) < 16) ta = fmaxf(ta, v); else tb = fmaxf(tb, v); }
        if (lane < 16) ta = fmaxf(ta, fabsf(P.a_sinks[lane]));
#pragma unroll
        for (int o = 32; o >= 1; o >>= 1) { aq = fmaxf(aq, __shfl_xor(aq, o)); ak = fmaxf(ak, __shfl_xor(ak, o)); bq = fmaxf(bq, __shfl_xor(bq, o)); bk = fmaxf(bk, __shfl_xor(bk, o)); ta = fmaxf(ta, __shfl_xor(ta, o)); tb = fmaxf(tb, __shfl_xor(tb, o)); }
        const float ra = 11.3137085f * LOG2E * aq * ak + LOG2E * ta + 1.0f, rb = 11.3137085f * LOG2E * bq * bk + LOG2E * tb + 1.0f;
        if (lane == 0) { float* mr = (float*)(ws + OFF_MREF); mr[0] = ra; mr[1] = rb; mr[2] = (ra < 60.0f && rb < 60.0f) ? 1.0f : 0.0f; }
    }
    for (int i = blockIdx.x * 512 + tid; i < S_; i += gridDim.x * 512) { ((float*)(ws + OFF_SS1))[i] = 0.f; ((float*)(ws + OFF_SSAB))[2 * i] = 0.f; ((float*)(ws + OFF_SSAB))[2 * i + 1] = 0.f; }
    for (int row = blockIdx.x * 8 + wid; row < S_; row += gridDim.x * 8) {
        const f32x4* xr = (const f32x4*)(P.x + (size_t)row * DM); bf16_t* xo = (bf16_t*)(ws + OFF_XB) + (size_t)row * DM; float ss = 0.f;
#pragma unroll 4
        for (int i = 0; i < 16; ++i) { const f32x4 v = xr[i * 64 + lane]; ss += (v[0] * v[0] + v[1] * v[1]) + (v[2] * v[2] + v[3] * v[3]);
            u32x2 w; w.x = cvt_pk_bf16(v[0], v[1]); w.y = cvt_pk_bf16(v[2], v[3]); *(u32x2*)(xo + (i * 64 + lane) * 4) = w; }
        ss = wave_sum(ss);
        if (lane == 0) ((float*)(ws + OFF_RSTD0))[row] = rsqrtf(ss * (1.0f / 4096.0f) + EPS_);
    }
    constexpr int J0 = 64 * 66, J1 = J0 + 64 * 32, J2 = J1 + 64 * 86, J3 = J2 + 64 * 86, J4 = J3 + 172 * 32, J5 = J4 + 128, J6 = J5 + 128;
    auto decode = [&](int it) -> TDesc {
        TDesc t;
        if (it < J0) { t = TDesc{P.w_in, P.norm_mix_g, (bf16_t*)(ws + OFF_WIN), 4096, NIN, it / 66, it % 66, (it % 66) * 128}; }
        else if (it < J1) { const int i = it - J0; t = TDesc{P.w_out, P.out_norm_g, (bf16_t*)(ws + OFF_WOUT), 4096, 4096, i / 32, i % 32, (i % 32) * 128}; }
        else if (it < J2) { const int i = it - J1; t = TDesc{P.w_gate, P.norm_ffn_g, (bf16_t*)(ws + OFF_WGU), 4096, DFF, i / 86, i % 86, (i % 86) * 256}; }
        else if (it < J3) { const int i = it - J2; t = TDesc{P.w_up, P.norm_ffn_g, (bf16_t*)(ws + OFF_WGU), 4096, DFF, i / 86, i % 86, (i % 86) * 256 + 128}; }
        else if (it < J4) { const int i = it - J3; t = TDesc{P.w_down, nullptr, (bf16_t*)(ws + OFF_WD), DFF, 4096, i / 32, i % 32, (i % 32) * 128}; }
        else if (it < J5) { const int i = it - J4; t = TDesc{P.cmp_w1, nullptr, (bf16_t*)(ws + OFF_W1), 4096, 256, i / 2, i % 2, (i % 2) * 128}; }
        else { const int i = it - J5; t = TDesc{P.cmp_w1 + 4096 * 256, nullptr, (bf16_t*)(ws + OFF_W1) + 256 * 4096, 4096, 256, i / 2, i % 2, (i % 2) * 128}; }
        return t;
    };
    {
        int it = blockIdx.x;
        if (it < J6) {
            TDesc tc = decode(it); TRegs rc; tconv_load(tc, rc);
            for (;;) {
                const int itn = it + gridDim.x; const bool more = itn < J6;
                TDesc tn = tc; TRegs rn = rc;
                if (more) { tn = decode(itn); tconv_load(tn, rn); }
                tconv_store(ldsw, tc, rc);
                if (!more) break;
                tc = tn; rc = rn; it = itn;
            }
        }
    }
}

__device__ __forceinline__ void norm_head(const bf16_t* src, bf16_t* dst, float g0, float g1, float scale, int lane) {
    const unsigned w = *(const unsigned*)(src + 2 * lane); float a = bf_lo(w), b = bf_hi(w);
    const float ss = wave_sum(a * a + b * b); const float r = rsqrtf(ss * (1.0f / 128.0f) + EPS_) * scale;
    *(unsigned*)(dst + 2 * lane) = cvt_pk_bf16(a * r * g0, b * r * g1);
}
__device__ void phase_norm(const Params& P, unsigned char* shm) {
    unsigned char* ws = P.ws; const bf16_t* proj = (const bf16_t*)(ws + OFF_PROJ);
    const int tid = threadIdx.x, wid = tid >> 6, lane = tid & 63;
    {
        bf16_t* T = (bf16_t*)shm;
        for (int it = blockIdx.x; it < 768; it += gridDim.x) {
            const int v = it >> 8, sb = it & 255, s0 = sb * 32;
            const int col = v == 0 ? 2560 : (v == 1 ? 6656 : 7680);
            bf16_t* dst = (bf16_t*)(ws + (v == 0 ? OFF_VA : (v == 1 ? OFF_VS : OFF_VW)));
#pragma unroll
            for (int i = 0; i < 4; ++i) { const int r = (tid >> 6) + 8 * i, ch = tid & 63;
                *(u32x4*)(T + r * 520 + ch * 8) = *(const u32x4*)(proj + (size_t)(s0 + r) * NINP + col + ch * 8); }
            __syncthreads();
#pragma unroll
            for (int k = 0; k < 4; ++k) { unsigned w[4];
#pragma unroll
                for (int e = 0; e < 4; ++e) w[e] = (unsigned)T[(8 * k + 2 * e) * 520 + tid] | ((unsigned)T[(8 * k + 2 * e + 1) * 520 + tid] << 16);
                u32x4 o; o.x = w[0]; o.y = w[1]; o.z = w[2]; o.w = w[3];
                *(u32x4*)(dst + (size_t)tid * S_ + s0 + 8 * k) = o; }
            __syncthreads();
        }
    }
    {
        const int sub = lane >> 4, e8 = (lane & 15) * 8;
        float gaq[8], gak[8], gbq[8], gks[8], gkw[8];
#pragma unroll
        for (int j = 0; j < 8; ++j) { gaq[j] = P.a_q_g[e8 + j] * QSCALE; gak[j] = P.a_k_g[e8 + j]; gbq[j] = P.b_q_g[e8 + j] * QSCALE; gks[j] = P.b_k_g[128 + e8 + j]; gkw[j] = P.b_k_g[256 + e8 + j]; }
        for (int s = blockIdx.x * 8 + wid; s < S_; s += gridDim.x * 8) {
            const bf16_t* pr = proj + (size_t)s * NINP;
#pragma unroll
            for (int grp = 0; grp < 11; ++grp) {
                const int scol = grp < 4 ? grp * 512 : (grp == 4 ? 2048 : (grp < 9 ? 3072 + (grp - 5) * 512 : (grp == 9 ? 6144 : 7168)));
                bf16_t* dst = grp < 4 ? (bf16_t*)(ws + OFF_QA) + (size_t)s * 2048 + grp * 512 : (grp == 4 ? (bf16_t*)(ws + OFF_KA) + (size_t)s * 512 :
                              (grp < 9 ? (bf16_t*)(ws + OFF_QB) + (size_t)s * 2048 + (grp - 5) * 512 : (grp == 9 ? (bf16_t*)(ws + OFF_KS) + (size_t)s * 512 : (bf16_t*)(ws + OFF_KW) + (size_t)s * 512)));
                const u32x4 w = *(const u32x4*)(pr + scol + sub * 128 + e8);
                float v[8]; v[0] = bf_lo(w.x); v[1] = bf_hi(w.x); v[2] = bf_lo(w.y); v[3] = bf_hi(w.y); v[4] = bf_lo(w.z); v[5] = bf_hi(w.z); v[6] = bf_lo(w.w); v[7] = bf_hi(w.w);
                float ss = ((v[0] * v[0] + v[1] * v[1]) + (v[2] * v[2] + v[3] * v[3])) + ((v[4] * v[4] + v[5] * v[5]) + (v[6] * v[6] + v[7] * v[7]));
                ss += __shfl_xor(ss, 8); ss += __shfl_xor(ss, 4); ss += __shfl_xor(ss, 2); ss += __shfl_xor(ss, 1);
                const float r = rsqrtf(ss * (1.0f / 128.0f) + EPS_);
                u32x4 o;
                if (grp < 4) { o.x = cvt_pk_bf16(v[0] * r * gaq[0], v[1] * r * gaq[1]); o.y = cvt_pk_bf16(v[2] * r * gaq[2], v[3] * r * gaq[3]); o.z = cvt_pk_bf16(v[4] * r * gaq[4], v[5] * r * gaq[5]); o.w = cvt_pk_bf16(v[6] * r * gaq[6], v[7] * r * gaq[7]); }
                else if (grp == 4) { o.x = cvt_pk_bf16(v[0] * r * gak[0], v[1] * r * gak[1]); o.y = cvt_pk_bf16(v[2] * r * gak[2], v[3] * r * gak[3]); o.z = cvt_pk_bf16(v[4] * r * gak[4], v[5] * r * gak[5]); o.w = cvt_pk_bf16(v[6] * r * gak[6], v[7] * r * gak[7]); }
                else if (grp < 9) { o.x = cvt_pk_bf16(v[0] * r * gbq[0], v[1] * r * gbq[1]); o.y = cvt_pk_bf16(v[2] * r * gbq[2], v[3] * r * gbq[3]); o.z = cvt_pk_bf16(v[4] * r * gbq[4], v[5] * r * gbq[5]); o.w = cvt_pk_bf16(v[6] * r * gbq[6], v[7] * r * gbq[7]); }
                else if (grp == 9) { o.x = cvt_pk_bf16(v[0] * r * gks[0], v[1] * r * gks[1]); o.y = cvt_pk_bf16(v[2] * r * gks[2], v[3] * r * gks[3]); o.z = cvt_pk_bf16(v[4] * r * gks[4], v[5] * r * gks[5]); o.w = cvt_pk_bf16(v[6] * r * gks[6], v[7] * r * gks[7]); }
                else { o.x = cvt_pk_bf16(v[0] * r * gkw[0], v[1] * r * gkw[1]); o.y = cvt_pk_bf16(v[2] * r * gkw[2], v[3] * r * gkw[3]); o.z = cvt_pk_bf16(v[4] * r * gkw[4], v[5] * r * gkw[5]); o.w = cvt_pk_bf16(v[6] * r * gkw[6], v[7] * r * gkw[7]); }
                *(u32x4*)(dst + sub * 128 + e8) = o;
            }
        }
    }
    {
        bf16_t* im = (bf16_t*)(ws + OFF_IM2);
        for (int r = blockIdx.x * 8 + wid; r < 4096; r += gridDim.x * 8) {
            const int c = r >> 11, g = (r >> 9) & 3, n = r & 511, colc = (c ? 5632 : 5120) + g * 128;
            const int sub = lane >> 4, ch = lane & 15;
#pragma unroll
            for (int itx = 0; itx < 8; ++itx) { const int l = itx * 4 + sub; u32x4 v = {0u, 0u, 0u, 0u};
                if (n < 511) { const u32x4 t = *(const u32x4*)(proj + (size_t)(16 * n + l) * NINP + colc + ch * 8);
                    const f32x4 p0 = *(const f32x4*)(P.pos_emb + (size_t)c * 4096 + l * 128 + ch * 8), p1 = *(const f32x4*)(P.pos_emb + (size_t)c * 4096 + l * 128 + ch * 8 + 4);
                    v.x = cvt_pk_bf16(bf_lo(t.x) + p0[0], bf_hi(t.x) + p0[1]); v.y = cvt_pk_bf16(bf_lo(t.y) + p0[2], bf_hi(t.y) + p0[3]);
                    v.z = cvt_pk_bf16(bf_lo(t.z) + p1[0], bf_hi(t.z) + p1[1]); v.w = cvt_pk_bf16(bf_lo(t.w) + p1[2], bf_hi(t.w) + p1[3]); }
                *(u32x4*)(im + (size_t)r * 4096 + l * 128 + ch * 8) = v; }
        }
    }
}

__device__ void phase_cmp2(const Params& P, unsigned char* shm) {
    unsigned char* ws = P.ws; const int tid = threadIdx.x, wid = tid >> 6, lane = tid & 63;
    const float* Hacc = (const float*)(ws + OFF_HACC);
    float* hl = (float*)shm + wid * 512;
    for (int rp = blockIdx.x * 8 + wid; rp < 2048; rp += gridDim.x * 8) {
        const int r = rp * 2, c = r >> 11, g = (r >> 9) & 3, n = r & 511;
        const f32x4 bb = *(const f32x4*)(P.cmp_b1 + c * 256 + 4 * lane);
#pragma unroll
        for (int rr = 0; rr < 2; ++rr) { f32x4 v = *(const f32x4*)(Hacc + (size_t)(r + rr) * 256 + 4 * lane) + bb;
#pragma unroll
            for (int j = 0; j < 4; ++j) { const float a = v[j]; v[j] = __uint_as_float(cvt_pk_bf16(a * __builtin_amdgcn_rcpf(1.0f + __expf(-1.5957691216057308f * (a + 0.044715f * a * a * a))), 0.f) << 16); }
            *(f32x4*)(hl + rr * 256 + 4 * lane) = v; }
        const float* w2 = P.cmp_w2 + (size_t)c * 256 * 128 + 2 * lane;
        float a0 = P.cmp_b2[c * 128 + 2 * lane], a1 = P.cmp_b2[c * 128 + 2 * lane + 1], b0 = a0, b1 = a1;
#pragma unroll 8
        for (int k = 0; k < 256; ++k) { const float h0 = hl[k], h1 = hl[256 + k];
            const float2 w = *(const float2*)(w2 + (size_t)k * 128); a0 += h0 * w.x; a1 += h0 * w.y; b0 += h1 * w.x; b1 += h1 * w.y; }
        if (c == 0) {
            const float gk0 = P.b_k_g[2 * lane], gk1 = P.b_k_g[2 * lane + 1];
            const float ra = rsqrtf(wave_sum(a0 * a0 + a1 * a1) * (1.0f / 128.0f) + EPS_), rb = rsqrtf(wave_sum(b0 * b0 + b1 * b1) * (1.0f / 128.0f) + EPS_);
            bf16_t* kc = (bf16_t*)(ws + OFF_KC) + ((size_t)g * 512 + n) * 128 + 2 * lane;
            *(unsigned*)kc = cvt_pk_bf16(a0 * ra * gk0, a1 * ra * gk1); *(unsigned*)(kc + 128) = cvt_pk_bf16(b0 * rb * gk0, b1 * rb * gk1);
        } else {
            bf16_t* vt = (bf16_t*)(ws + OFF_VCT) + ((size_t)g * 128 + 2 * lane) * 512 + n;
            *(unsigned*)vt = cvt_pk_bf16(a0, b0); *(unsigned*)(vt + 512) = cvt_pk_bf16(a1, b1);
        }
    }
}

constexpr int AL_K = 0, AL_V = 16384, AL_BUF = 32768, AL_BIAS = 65536, AL_SC = 67840, AL_FS = 133376;
#define NEG_INF (-__builtin_inff())

template <int MODE, int PASS>
__device__ __forceinline__ void attn_tiles(unsigned char* shm, const bf16_t* kbase, int kstride, const bf16_t* vbase, int vstride, int kt_lo, int kt_hi,
                                           const bf16x8 (&qf)[2][4], float (&m_)[2], float (&l_)[2], const float (&inv2)[2], f32x4 (&O)[2][8],
                                           unsigned sm0, unsigned sm1, unsigned sm2, unsigned sm3, int query, int hp, int qs, int qlo, int hb0, int hb1, bool stats3) {
    const bool stats = (MODE != 2) && stats3;
    constexpr bool FIX = (MODE != 2) && (PASS == 0);
    const int tid = threadIdx.x, lane = tid & 63, n = lane & 15, qq = lane >> 4;
    const float* biasL = (const float*)(shm + AL_BIAS);
    const float bfar0 = biasL[hb0 * 132 + 128], bfar1 = biasL[hb1 * 132 + 128];
    float carry = 0.f;
    const int wid_ = __builtin_amdgcn_readfirstlane(tid >> 6);
    PG8_LAS unsigned char* shmL = (PG8_LAS unsigned char*)shm;
#define ATT_DMA(KT, B) do { const int key0_ = (KT) * 64; _Pragma("unroll") for (int i = 0; i < 2; ++i) { const int ci = wid_ * 2 + i; \
        const int r_ = 4 * ci + (lane >> 4), c_ = (lane & 15) ^ (r_ & 15); \
        __builtin_amdgcn_global_load_lds((const unsigned*)(kbase + (size_t)(key0_ + r_) * kstride + c_ * 8), (PG8_LAS unsigned*)(shmL + (B) * AL_BUF + AL_K + ci * 1024), 16, 0, 0); \
        const int d_ = 8 * ci + (lane >> 3), s_ = (lane & 7) ^ ((d_ >> 1) & 7); \
        __builtin_amdgcn_global_load_lds((const unsigned*)(vbase + (size_t)d_ * vstride + key0_ + s_ * 8), (PG8_LAS unsigned*)(shmL + (B) * AL_BUF + AL_V + ci * 1024), 16, 0, 0); } } while (0)
    ATT_DMA(kt_lo, 0);
    asm volatile("s_waitcnt vmcnt(0)" ::: "memory");
    __syncthreads();
#pragma unroll 1
    for (int kt = kt_lo; kt <= kt_hi; ++kt) {
        const int cur = (kt - kt_lo) & 1;
        if (kt < kt_hi) ATT_DMA(kt + 1, cur ^ 1);
        const unsigned char* kl = shm + cur * AL_BUF + AL_K; const unsigned char* vl = shm + cur * AL_BUF + AL_V;
        const int key0 = kt * 64;
        bool selb = true;
        if (MODE == 3) { const unsigned w = kt < 32 ? sm0 : (kt < 64 ? sm1 : (kt < 96 ? sm2 : sm3)); selb = (w >> (kt & 31)) & 1u; }
        bool doit = true;
        if (MODE == 3) doit = __ballot(selb) != 0ull;
        if (doit) {
            f32x4 Sx[2][4];
#pragma unroll
            for (int tq = 0; tq < 2; ++tq)
#pragma unroll
                for (int st = 0; st < 4; ++st) Sx[tq][st] = (f32x4){0.f, 0.f, 0.f, 0.f};
#pragma unroll
            for (int st = 0; st < 4; ++st)
#pragma unroll
                for (int dc = 0; dc < 4; ++dc) {
                    const bf16x8 kf = *(const bf16x8*)(kl + (st * 16 + n) * 256 + (((dc * 4 + qq) ^ n) * 16));
                    Sx[0][st] = __builtin_amdgcn_mfma_f32_16x16x32_bf16(kf, qf[0][dc], Sx[0][st], 0, 0, 0);
                    Sx[1][st] = __builtin_amdgcn_mfma_f32_16x16x32_bf16(kf, qf[1][dc], Sx[1][st], 0, 0, 0);
                }
            const int dmin = (MODE == 2) ? qlo - (16 * (key0 + 63) + 31) : qlo - (key0 + 63);
            const int dmax = (MODE == 2) ? qlo + 15 - (16 * key0 + 31) : qlo + 15 - key0;
            const bool fast = (MODE != 0) && dmin >= 128 && (MODE != 1 || dmax < 512);
            if (fast) {
#pragma unroll
                for (int tq = 0; tq < 2; ++tq) {
                    const float bc = tq ? bfar1 : bfar0;
                    if (FIX && stats) {
                        float tm = fmaxf(fmaxf(fmaxf(Sx[tq][0][0], Sx[tq][0][1]), fmaxf(Sx[tq][0][2], Sx[tq][0][3])), fmaxf(fmaxf(Sx[tq][1][0], Sx[tq][1][1]), fmaxf(Sx[tq][1][2], Sx[tq][1][3])));
                        tm = fmaxf(tm, fmaxf(fmaxf(fmaxf(Sx[tq][2][0], Sx[tq][2][1]), fmaxf(Sx[tq][2][2], Sx[tq][2][3])), fmaxf(fmaxf(Sx[tq][3][0], Sx[tq][3][1]), fmaxf(Sx[tq][3][2], Sx[tq][3][3]))));
                        tm = (MODE == 3 && !selb) ? NEG_INF : tm + bc;
                        tm = fmaxf(tm, __shfl_xor(tm, 16)); tm = fmaxf(tm, __shfl_xor(tm, 32));
                        m_[tq] = fmaxf(m_[tq], tm);
                    } else if ((PASS != 2 && FIX) || (MODE == 2 && PASS == 1 && stats3)) {
                        const float cc = (MODE == 3 && !selb) ? NEG_INF : bc - m_[tq];
                        float ps = 0.f;
#pragma unroll
                        for (int st = 0; st < 4; ++st)
#pragma unroll
                            for (int r = 0; r < 4; ++r) { const float p = __builtin_amdgcn_exp2f(Sx[tq][st][r] + cc); Sx[tq][st][r] = p; ps += p; }
                        l_[tq] += ps;
                    } else if (PASS != 2) {
                        float tm = fmaxf(fmaxf(fmaxf(Sx[tq][0][0], Sx[tq][0][1]), fmaxf(Sx[tq][0][2], Sx[tq][0][3])), fmaxf(fmaxf(Sx[tq][1][0], Sx[tq][1][1]), fmaxf(Sx[tq][1][2], Sx[tq][1][3])));
                        tm = fmaxf(tm, fmaxf(fmaxf(fmaxf(Sx[tq][2][0], Sx[tq][2][1]), fmaxf(Sx[tq][2][2], Sx[tq][2][3])), fmaxf(fmaxf(Sx[tq][3][0], Sx[tq][3][1]), fmaxf(Sx[tq][3][2], Sx[tq][3][3]))));
                        tm = (MODE == 3 && !selb) ? NEG_INF : tm + bc;
                        tm = fmaxf(tm, __shfl_xor(tm, 16)); tm = fmaxf(tm, __shfl_xor(tm, 32));
                        const float mn = fmaxf(m_[tq], tm), mu = (mn == NEG_INF) ? 0.f : mn;
                        const float alpha = __builtin_amdgcn_exp2f(m_[tq] - mu);
                        m_[tq] = mn;
                        const float cc = (MODE == 3 && !selb) ? NEG_INF : bc - mu;
                        float ps = 0.f;
#pragma unroll
                        for (int st = 0; st < 4; ++st)
#pragma unroll
                            for (int r = 0; r < 4; ++r) { const float p = __builtin_amdgcn_exp2f(Sx[tq][st][r] + cc); Sx[tq][st][r] = p; ps += p; }
                        l_[tq] = l_[tq] * alpha + ps;
                        if (PASS == 0) { if (__ballot(alpha != 1.0f) != 0ull) {
#pragma unroll
                            for (int dt = 0; dt < 8; ++dt) O[tq][dt] = O[tq][dt] * alpha; } }
                    } else {
                        const float mu = (m_[tq] == NEG_INF) ? 0.f : m_[tq]; const float cc = bc - mu;
#pragma unroll
                        for (int st = 0; st < 4; ++st)
#pragma unroll
                            for (int r = 0; r < 4; ++r) Sx[tq][st][r] = __builtin_amdgcn_exp2f(Sx[tq][st][r] + cc) * inv2[tq];
                    }
                }
            } else {
#pragma unroll
                for (int st = 0; st < 4; ++st)
#pragma unroll
                    for (int r = 0; r < 4; ++r) {
                        const int key = key0 + st * 16 + qq * 4 + r;
                        const int dist = (MODE == 2) ? query - (16 * key + 31) : query - key;
                        bool valid = dist >= 0;
                        if (MODE == 0) valid = valid && dist < 128;
                        if (MODE == 1) valid = valid && dist < 512;
                        if (MODE == 3) valid = valid && selb;
                        int idx = dist < 0 ? 0 : dist; idx = idx > 128 ? 128 : idx;
                        const float b0 = biasL[hb0 * 132 + idx], b1 = biasL[hb1 * 132 + idx];
                        Sx[0][st][r] = valid ? Sx[0][st][r] + b0 : NEG_INF;
                        Sx[1][st][r] = valid ? Sx[1][st][r] + b1 : NEG_INF;
                    }
#pragma unroll
                for (int tq = 0; tq < 2; ++tq) {
                    if (FIX && stats) {
                        float tm = NEG_INF;
#pragma unroll
                        for (int st = 0; st < 4; ++st)
#pragma unroll
                            for (int r = 0; r < 4; ++r) tm = fmaxf(tm, Sx[tq][st][r]);
                        tm = fmaxf(tm, __shfl_xor(tm, 16)); tm = fmaxf(tm, __shfl_xor(tm, 32));
                        m_[tq] = fmaxf(m_[tq], tm);
                    } else if ((PASS != 2 && FIX) || (MODE == 2 && PASS == 1 && stats3)) {
                        float ps = 0.f;
#pragma unroll
                        for (int st = 0; st < 4; ++st)
#pragma unroll
                            for (int r = 0; r < 4; ++r) { const float p = __builtin_amdgcn_exp2f(Sx[tq][st][r] - m_[tq]); Sx[tq][st][r] = p; ps += p; }
                        l_[tq] += ps;
                    } else if (PASS != 2) {
                        float tm = NEG_INF;
#pragma unroll
                        for (int st = 0; st < 4; ++st)
#pragma unroll
                            for (int r = 0; r < 4; ++r) tm = fmaxf(tm, Sx[tq][st][r]);
                        tm = fmaxf(tm, __shfl_xor(tm, 16)); tm = fmaxf(tm, __shfl_xor(tm, 32));
                        const float mn = fmaxf(m_[tq], tm), mu = (mn == NEG_INF) ? 0.f : mn;
                        const float alpha = __builtin_amdgcn_exp2f(m_[tq] - mu);
                        m_[tq] = mn;
                        float ps = 0.f;
#pragma unroll
                        for (int st = 0; st < 4; ++st)
#pragma unroll
                            for (int r = 0; r < 4; ++r) { const float p = __builtin_amdgcn_exp2f(Sx[tq][st][r] - mu); Sx[tq][st][r] = p; ps += p; }
                        l_[tq] = l_[tq] * alpha + ps;
                        if (PASS == 0) {
#pragma unroll
                            for (int dt = 0; dt < 8; ++dt) O[tq][dt] = O[tq][dt] * alpha;
                        }
                    } else {
                        const float mu = (m_[tq] == NEG_INF) ? 0.f : m_[tq];
#pragma unroll
                        for (int st = 0; st < 4; ++st)
#pragma unroll
                            for (int r = 0; r < 4; ++r) Sx[tq][st][r] = __builtin_amdgcn_exp2f(Sx[tq][st][r] - mu) * inv2[tq];
                    }
                }
            }
            if (PASS == 2) {
                float* scL = (float*)(shm + AL_SC) + hp * 128 * 64 + qs * 16 + n;
                float yprev = carry;
#pragma unroll
                for (int st = 0; st < 4; ++st) {
                    const float a = ((Sx[0][st][0] + Sx[0][st][1]) + (Sx[0][st][2] + Sx[0][st][3])) + ((Sx[1][st][0] + Sx[1][st][1]) + (Sx[1][st][2] + Sx[1][st][3]));
                    const float y = __shfl(Sx[0][st][3] + Sx[1][st][3], (lane + 48) & 63);
                    scL[(16 * kt + 4 * st + qq) * 64] = a + ((qq > 0) ? y : yprev);
                    yprev = y;
                }
                carry = yprev;
            }
            if (PASS != 1 && !stats) {
                bf16x8 pb[2][2];
#pragma unroll
                for (int tq = 0; tq < 2; ++tq)
#pragma unroll
                    for (int ch = 0; ch < 2; ++ch) { u32x4 w; w.x = cvt_pk_bf16(Sx[tq][2 * ch][0], Sx[tq][2 * ch][1]); w.y = cvt_pk_bf16(Sx[tq][2 * ch][2], Sx[tq][2 * ch][3]);
                        w.z = cvt_pk_bf16(Sx[tq][2 * ch + 1][0], Sx[tq][2 * ch + 1][1]); w.w = cvt_pk_bf16(Sx[tq][2 * ch + 1][2], Sx[tq][2 * ch + 1][3]); pb[tq][ch] = __builtin_bit_cast(bf16x8, w); }
#pragma unroll
                for (int dt = 0; dt < 8; ++dt)
#pragma unroll
                    for (int ch = 0; ch < 2; ++ch) {
                        const unsigned char* vp = vl + (dt * 16 + n) * 128 + (qq & 1) * 8;
                        const u32x2 lo = *(const u32x2*)(vp + (((4 * ch + (qq >> 1)) ^ (n >> 1)) * 16)), hi = *(const u32x2*)(vp + (((4 * ch + 2 + (qq >> 1)) ^ (n >> 1)) * 16));
                        u32x4 vv; vv.x = lo.x; vv.y = lo.y; vv.z = hi.x; vv.w = hi.y;
                        const bf16x8 vf = __builtin_bit_cast(bf16x8, vv);
                        O[0][dt] = __builtin_amdgcn_mfma_f32_16x16x32_bf16(vf, pb[0][ch], O[0][dt], 0, 0, 0);
                        O[1][dt] = __builtin_amdgcn_mfma_f32_16x16x32_bf16(vf, pb[1][ch], O[1][dt], 0, 0, 0);
                    }
            }
        }
        asm volatile("s_waitcnt vmcnt(0)" ::: "memory");
        __syncthreads();
    }
#undef ATT_DMA
}

template <int MODE>
__device__ void attn_item(const Params& P, unsigned char* shm, int qb, int g, int dry, bool refill = true) {
    unsigned char* ws = P.ws;
    const int tid = threadIdx.x, wid = tid >> 6, lane = tid & 63, n = lane & 15, qq = lane >> 4;
    const int qs = wid >> 1, hp = wid & 1;
    const int s0 = qb * 64, query = (MODE == 3) ? s0 + wid * 8 + (n >> 1) : s0 + qs * 16 + n;
    const int hb0 = (MODE == 3) ? (n & 1) : 2 * hp, hb1 = (MODE == 3) ? 2 + (n & 1) : 2 * hp + 1;
    const int qlo = (MODE == 3) ? s0 + wid * 8 : s0 + qs * 16;
    const bf16_t* qbuf = (const bf16_t*)(ws + (MODE == 0 ? OFF_QA : OFF_QB));
    const bf16_t* kbase; const bf16_t* vbase; int kstride, vstride;
    if (MODE == 0) { kbase = (const bf16_t*)(ws + OFF_KA) + g * 128; kstride = 512; vbase = (const bf16_t*)(ws + OFF_VA) + (size_t)g * 128 * S_; vstride = S_; }
    else if (MODE == 1) { kbase = (const bf16_t*)(ws + OFF_KW) + g * 128; kstride = 512; vbase = (const bf16_t*)(ws + OFF_VW) + (size_t)g * 128 * S_; vstride = S_; }
    else if (MODE == 3) { kbase = (const bf16_t*)(ws + OFF_KS) + g * 128; kstride = 512; vbase = (const bf16_t*)(ws + OFF_VS) + (size_t)g * 128 * S_; vstride = S_; }
    else { kbase = (const bf16_t*)(ws + OFF_KC) + (size_t)g * 512 * 128; kstride = 128; vbase = (const bf16_t*)(ws + OFF_VCT) + (size_t)g * 128 * 512; vstride = 512; }
    const int hbase = g * 4;
    float* biasL = (float*)(shm + AL_BIAS);
    __syncthreads();
    if (refill) {
        for (int i = tid; i < 4 * 129; i += 512) { const int hh = i / 129, d = i - hh * 129; biasL[hh * 132 + d] = P.rel_bias[(int)T5B[d] * 32 + (MODE == 0 ? 0 : 16) + g * 4 + hh] * LOG2E; }
        __syncthreads();
    }
    bf16x8 qf[2][4];
#pragma unroll
    for (int tq = 0; tq < 2; ++tq)
#pragma unroll
        for (int dc = 0; dc < 4; ++dc) qf[tq][dc] = *(const bf16x8*)(qbuf + (size_t)query * 2048 + (hbase + (tq ? hb1 : hb0)) * 128 + dc * 32 + qq * 8);
    const float mref = ((const float*)(ws + OFF_MREF))[MODE == 0 ? 0 : 1]; const bool fixok = ((const float*)(ws + OFF_MREF))[2] != 0.f; const bool fix = (MODE != 2) && fixok;
    float m_[2], l_[2];
#pragma unroll
    for (int tq = 0; tq < 2; ++tq) {
        if (fix || (MODE == 2 && fixok)) { m_[tq] = mref; l_[tq] = (MODE == 0 && qq == 0) ? __builtin_amdgcn_exp2f(P.a_sinks[hbase + (tq ? hb1 : hb0)] * LOG2E - mref) : 0.0f; }
        else if (MODE == 0) { m_[tq] = P.a_sinks[hbase + (tq ? hb1 : hb0)] * LOG2E; l_[tq] = qq == 0 ? 1.0f : 0.0f; } else { m_[tq] = NEG_INF; l_[tq] = 0.f; } }
    unsigned sm0 = 0, sm1 = 0, sm2 = 0, sm3 = 0;
    if (MODE == 3) { const u32x4 w = *(const u32x4*)((const unsigned*)(ws + OFF_SEL) + ((size_t)g * S_ + query) * 4); sm0 = w.x; sm1 = w.y; sm2 = w.z; sm3 = w.w; }
    int kt_lo, kt_hi;
    if (MODE == 0) { kt_lo = qb - 2 < 0 ? 0 : qb - 2; kt_hi = qb; }
    else if (MODE == 1) { kt_lo = qb - 8 < 0 ? 0 : qb - 8; kt_hi = qb; }
    else if (MODE == 2) { kt_lo = 0; kt_hi = qb >> 4; }
    else { kt_lo = 0; kt_hi = qb; }
    float inv2[2] = {1.f, 1.f};
    f32x4 O[2][8];
    __builtin_amdgcn_s_waitcnt(0);
    if (MODE == 2) {
        attn_tiles<MODE, 1>(shm, kbase, kstride, vbase, vstride, kt_lo, kt_hi, qf, m_, l_, inv2, O, sm0, sm1, sm2, sm3, query, hp, qs, qlo, hb0, hb1, fixok);
#pragma unroll
        for (int tq = 0; tq < 2; ++tq) { float l = l_[tq]; l += __shfl_xor(l, 16); l += __shfl_xor(l, 32); inv2[tq] = l > 0.f ? 1.0f / l : 0.f; }
    }
#pragma unroll
    for (int tq = 0; tq < 2; ++tq)
#pragma unroll
        for (int dt = 0; dt < 8; ++dt) O[tq][dt] = (f32x4){0.f, 0.f, 0.f, 0.f};
#pragma unroll 1
    for (int sweep = (MODE != 2 && !fix) ? 0 : 1; sweep < 2; ++sweep) {
        if (MODE == 0 && sweep == 1 && !fix) {
#pragma unroll
            for (int tq = 0; tq < 2; ++tq) l_[tq] = qq == 0 ? __builtin_amdgcn_exp2f(P.a_sinks[hbase + (tq ? hb1 : hb0)] * LOG2E - m_[tq]) : 0.0f; }
        attn_tiles<MODE, (MODE == 2 ? 2 : 0)>(shm, kbase, kstride, vbase, vstride, kt_lo, kt_hi, qf, m_, l_, inv2, O, sm0, sm1, sm2, sm3, query, hp, qs, qlo, hb0, hb1, sweep == 0); }
    float* obuf = P.out;
    bf16_t* onb = (bf16_t*)(ws + OFF_ON);
    float ssq = 0.f;
    if (!(MODE >= 2 && dry))
#pragma unroll
    for (int tq = 0; tq < 2; ++tq) {
        float sc;
        if (MODE == 2) sc = 1.0f;
        else { float l = l_[tq]; l += __shfl_xor(l, 16); l += __shfl_xor(l, 32); sc = l > 0.f ? 1.0f / l : 0.f; }
        const int h = hbase + (tq ? hb1 : hb0);
        float gold = 1.0f;
        if (MODE >= 2) sc *= __builtin_amdgcn_rcpf(1.0f + __expf(-((const float*)(ws + OFF_GACC))[(size_t)query * 48 + h * 3 + (MODE == 2 ? 0 : 1)]));
        if (MODE == 2) gold = __builtin_amdgcn_rcpf(1.0f + __expf(-((const float*)(ws + OFF_GACC))[(size_t)query * 48 + h * 3 + 2]));
        float* op = obuf + (size_t)query * DM + (MODE == 0 ? 0 : 2048) + h * 128 + qq * 4;
        f32x4 oldv[8];
        if (MODE >= 2) {
#pragma unroll
            for (int dt = 0; dt < 8; ++dt) oldv[dt] = *(const f32x4*)(op + dt * 16);
        }
#pragma unroll
        for (int dt = 0; dt < 8; ++dt) { f32x4 v = O[tq][dt] * sc; if (MODE >= 2) v = v + oldv[dt] * gold;
            if (MODE == 0 || MODE == 3) {
                u32x2 w; w.x = cvt_pk_bf16(v[0], v[1]); w.y = cvt_pk_bf16(v[2], v[3]);
                *(u32x2*)(onb + (size_t)query * DM + (MODE == 0 ? 0 : 2048) + h * 128 + qq * 4 + dt * 16) = w;
                ssq += (v[0] * v[0] + v[1] * v[1]) + (v[2] * v[2] + v[3] * v[3]);
            } else *(f32x4*)(op + dt * 16) = v; }
    }
    if ((MODE == 0 || MODE == 3) && !(MODE >= 2 && dry)) {
        ssq += __shfl_xor(ssq, 16); ssq += __shfl_xor(ssq, 32);
        if (MODE == 3) ssq += __shfl_xor(ssq, 1);
        if (qq == 0 && (MODE != 3 || (n & 1) == 0)) atomicAdd((float*)(ws + OFF_SSAB) + 2 * query + (MODE == 0 ? 0 : 1), ssq);
    }
    if (MODE == 2) {
        __syncthreads();
        const float* sc0 = (const float*)(shm + AL_SC); float* fs = (float*)(shm + AL_FS) + wid * 128;
        const int cur = qb, j0 = lane, j1 = lane + 64;
        for (int e = 0; e < 8; ++e) {
            const int ql = wid * 8 + e;
            float v0 = -1.f, v1 = -1.f;
            if (j0 <= cur) { v0 = sc0[j0 * 64 + ql] + sc0[(128 + j0) * 64 + ql]; if (j0 == 0 || j0 == cur || j0 == cur - 1) v0 = 1e6f; }
            if (j1 <= cur) { v1 = sc0[j1 * 64 + ql] + sc0[(128 + j1) * 64 + ql]; if (j1 == cur || j1 == cur - 1) v1 = 1e6f; }
            fs[j0] = v0; fs[j1] = v1;
            __builtin_amdgcn_wave_barrier();
            int r0 = 0, r1 = 0;
            for (int jj = 0; jj <= cur; ++jj) { const float o = fs[jj]; r0 += (o > v0 || (o == v0 && jj < j0)) ? 1 : 0; r1 += (o > v1 || (o == v1 && jj < j1)) ? 1 : 0; }
            const unsigned long long b0 = __ballot(j0 <= cur && r0 < 16), b1 = __ballot(j1 <= cur && r1 < 16);
            if (lane == 0) { u32x4 w; w.x = (unsigned)b0; w.y = (unsigned)(b0 >> 32); w.z = (unsigned)b1; w.w = (unsigned)(b1 >> 32);
                *(u32x4*)((unsigned*)(ws + OFF_SEL) + ((size_t)g * S_ + s0 + ql) * 4) = w; }
            __builtin_amdgcn_wave_barrier();
        }
    }
}
template <int MODE>
__device__ __forceinline__ void attn_phase(const Params& P, unsigned char* shm, int dry, int first = -1, int stride = 0) {
    if (first < 0) { first = blockIdx.x; stride = gridDim.x; }
    for (int it = first; it < 512; it += stride) {
        const int j = it & 255, g = (j & 7) >> 1, li = ((j & 1) << 5) | (j >> 3); const int qb = it < 256 ? li : 127 - li;
        attn_item<MODE>(P, shm, qb, g, dry);
    }
}

__device__ void phase_outnorm(const Params& P) {
    const int tid = threadIdx.x, wid = tid >> 6, lane = tid & 63;
    bf16_t* on = (bf16_t*)(P.ws + OFF_ON);
    for (int s = blockIdx.x * 8 + wid; s < S_; s += gridDim.x * 8) {
        const f32x4* r = (const f32x4*)(P.out + (size_t)s * DM);
#pragma unroll
        for (int grp = 0; grp < 2; ++grp) {
            f32x4 v[8]; float ss = 0.f;
#pragma unroll
            for (int i = 0; i < 8; ++i) { v[i] = r[grp * 512 + i * 64 + lane]; ss += (v[i][0] * v[i][0] + v[i][1] * v[i][1]) + (v[i][2] * v[i][2] + v[i][3] * v[i][3]); }
            ss = wave_sum(ss); const float rr = rsqrtf(ss * (1.0f / 2048.0f) + EPS_);
#pragma unroll
            for (int i = 0; i < 8; ++i) { u32x2 w; w.x = cvt_pk_bf16(v[i][0] * rr, v[i][1] * rr); w.y = cvt_pk_bf16(v[i][2] * rr, v[i][3] * rr);
                *(u32x2*)(on + (size_t)s * DM + (grp * 512 + i * 64 + lane) * 4) = w; }
        }
    }
}

__device__ __forceinline__ void cmp_slc_phase(const Params& P, unsigned char* shm, int dry) {
    int prev_g = -1;
    for (int it = blockIdx.x; it < 512; it += gridDim.x) {
        const int j = it & 255, g = (j & 7) >> 1, li = ((j & 1) << 5) | (j >> 3); const int qb = it < 256 ? li : 127 - li;
        attn_item<2>(P, shm, qb, g, dry, g != prev_g); prev_g = g;
        __builtin_amdgcn_fence(__ATOMIC_RELEASE, "workgroup"); __syncthreads(); __builtin_amdgcn_fence(__ATOMIC_ACQUIRE, "workgroup");
        attn_item<3>(P, shm, qb, g, dry, false);
    }
}

__device__ void phase_fixup(const Params& P, int pm_only, int first, int stride) {
    const float* stL = (const float*)(P.ws + OFF_STL); const float* stG = (const float*)(P.ws + OFF_STG); const float* stU = (const float*)(P.ws + OFF_STU);
    bf16_t* hf = (bf16_t*)(P.ws + OFF_HF);
    constexpr int NC4 = DFF / 4;
    const int nit = pm_only < 0 ? 64 * NC4 : 2 * NC4;
    for (int it = first; it < nit; it += stride) {
        const int c4 = it % NC4, pr = it / NC4 + (pm_only < 0 ? 0 : 2 * pm_only), rr = pr & 1, pm = pr >> 1, col = c4 * 4;
        f32x4 L0 = {0.f, 0.f, 0.f, 0.f}, L1 = {0.f, 0.f, 0.f, 0.f};
        if (pm > 0) { L0 = *(const f32x4*)(stL + ((size_t)(pm - 1) * 2 + 0) * DFF + col); L1 = *(const f32x4*)(stL + ((size_t)(pm - 1) * 2 + 1) * DFF + col); }
        const f32x4 F0 = *(const f32x4*)(stG + ((size_t)pm * 2 + 0) * DFF + col), F1 = *(const f32x4*)(stG + ((size_t)pm * 2 + 1) * DFF + col);
        const f32x4 uu = *(const f32x4*)(stU + ((size_t)pm * 2 + rr) * DFF + col);
        const f32x4 g2 = rr ? L1 : L0, g1 = rr ? F0 : L1, g0 = rr ? F1 : F0;
        const f32x4 w0 = *(const f32x4*)(P.conv_w + col), w1 = *(const f32x4*)(P.conv_w + DFF + col), w2 = *(const f32x4*)(P.conv_w + 2 * DFF + col), cb = *(const f32x4*)(P.conv_b + col);
        const f32x4 z = cb + w0 * g2 + w1 * g1 + w2 * g0;
        f32x4 hv;
#pragma unroll
        for (int j = 0; j < 4; ++j) hv[j] = z[j] * __builtin_amdgcn_rcpf(1.0f + __expf(-z[j])) * uu[j];
        u32x2 w; w.x = cvt_pk_bf16(hv[0], hv[1]); w.y = cvt_pk_bf16(hv[2], hv[3]);
        *(u32x2*)(hf + (size_t)(pm * 256 + rr) * DFF + col) = w;
    }
}

__device__ __forceinline__ void phase3(const Params& P, unsigned char* shm, int dry) {
    unsigned char* ws = P.ws; const int b = blockIdx.x, G = gridDim.x;
    if (b < 64) {
        const int kh = b >> 5; pg8::Gemm g{(const bf16_t*)(ws + OFF_IM2) + kh * 2048, (const bf16_t*)(ws + OFF_W1) + kh * 2048, 4096, 512, 2048, 4096}; pg8::StaticOrder so; so.init(4096, 512, 32, b & 31);
        pg8::Unit u0; const bool useful = so.next(0, u0) && (u0.pm >> 3) == u0.pn;
        if (useful) { EpiCmp e{(float*)(ws + OFF_HACC)}; pg8::gemm_phase<EpiCmp, pg8::StaticOrder, false>((PG8_LAS unsigned char*)shm, g, so, e, nullptr); } }
    else if (b < 128) {
        const int kh = (b - 64) >> 5; pg8::Gemm g{(const bf16_t*)(ws + OFF_XB) + kh * 2048, (const bf16_t*)(ws + OFF_WIN) + (size_t)8192 * DM + kh * 2048, S_, 256, 2048, 4096}; pg8::StaticOrder so; so.init(S_, 256, 32, (b - 64) & 31);
        EpiGates e{(float*)(ws + OFF_GACC), (const float*)(ws + OFF_RSTD0)}; pg8::gemm_phase<EpiGates, pg8::StaticOrder, false>((PG8_LAS unsigned char*)shm, g, so, e, nullptr); }
    unsigned* ctr = (unsigned*)(ws + OFF_QCTR);
    volatile LAS unsigned* qw = (volatile LAS unsigned*)(LAS unsigned char*)(shm + LDS_STAGE + 64);
    unsigned nxt = 0;
    if (threadIdx.x == 0) nxt = atomicAdd(ctr, 1u);
    for (;;) {
        __syncthreads();
        if (threadIdx.x == 0) qw[0] = nxt;
        __syncthreads();
        const int it = (int)qw[0];
        if (it >= 1024) break;
        if (threadIdx.x == 0) nxt = atomicAdd(ctr, 1u);
        const int i5 = it & 511, j = i5 & 255, g = j >> 6, qb = i5 < 256 ? (j & 63) : 127 - (j & 63);
        if (it < 512) attn_item<1>(P, shm, qb, g, dry); else attn_item<0>(P, shm, qb, g, dry);
    }
}


#define XB_TMO      128
#define XB_XCNT(j)  (256  + 64 * (j))
#define XB_XSUB(j)  (1280 + 64 * (j))
#define XB_XGEN(j)  (2304 + 64 * (j))
#define XB_TOP      3328
#define XB_TOPGEN   3392
#define XCD_BAR_WORDS 3456
#define XB_SPIN_CAP (1u << 18)

__device__ __forceinline__ unsigned xb_ld(unsigned* p)              { return __hip_atomic_load(p, __ATOMIC_RELAXED, __HIP_MEMORY_SCOPE_AGENT); }
__device__ __forceinline__ unsigned xb_add(unsigned* p, unsigned v) { return __hip_atomic_fetch_add(p, v, __ATOMIC_RELAXED, __HIP_MEMORY_SCOPE_AGENT); }
__device__ __forceinline__ unsigned xb_xcc_id() { return (unsigned)__builtin_amdgcn_s_getreg((3 << 11) | 20) & 0xFu; }
#define XB_SPIN(cond, bar) do { unsigned _sp = 0; while (cond) { __builtin_amdgcn_s_sleep(1); \
    if ((++_sp & 255u) == 0u) { if (xb_ld(&(bar)[XB_TMO])) break; if (_sp > XB_SPIN_CAP) { atomicAdd(&(bar)[XB_TMO], 1u); break; } } } } while (0)

struct XcdBarrier {
    unsigned* bar; unsigned x;
    volatile LAS unsigned* st;
};

__device__ __forceinline__ XcdBarrier xcd_barrier_post(unsigned* bar, volatile LAS unsigned* st) {
    XcdBarrier b; b.bar = bar; b.x = xb_xcc_id(); b.st = st;
    if (threadIdx.x == 0) (void)xb_add(&bar[XB_XCNT(b.x)], 1u);
    return b;
}
__device__ __forceinline__ void xcd_barrier_complete(unsigned* bar, unsigned x, unsigned& nloc, unsigned& nx) {
    const unsigned G = gridDim.x * gridDim.y * gridDim.z;
    unsigned sum, cnt, mine, sp = 0u;
    for (;;) {
        sum = 0u; cnt = 0u; mine = 0u;
#pragma unroll
        for (unsigned j = 0; j < 16; ++j) { const unsigned c = xb_ld(&bar[XB_XCNT(j)]); sum += c; cnt += (c > 0u) ? 1u : 0u; mine = (j == x) ? c : mine; }
        if (sum == G) break;
        __builtin_amdgcn_s_sleep(1);
        if ((++sp & 255u) == 0u) { if (xb_ld(&bar[XB_TMO])) break; if (sp > XB_SPIN_CAP) { atomicAdd(&bar[XB_TMO], 1u); break; } }
    }
    nloc = mine > 0u ? mine : 1u; nx = cnt > 0u ? cnt : 1u;
}

__device__ __forceinline__ void xcd_barrier(const XcdBarrier& b) {
    asm volatile("s_waitcnt vmcnt(0)" ::: "memory");
    __syncthreads();
    if (threadIdx.x == 0) {
        unsigned* bar = b.bar;
        __builtin_amdgcn_s_waitcnt(0);
        unsigned nloc = b.st[0], nx = b.st[1];
        if (nloc == 0u) { xcd_barrier_complete(bar, b.x, nloc, nx); b.st[0] = nloc; b.st[1] = nx; }
        const unsigned old = xb_add(&bar[XB_XSUB(b.x)], 1u);
        const unsigned gen = old / nloc;
        if (old + 1u == (gen + 1u) * nloc) {
            __builtin_amdgcn_fence(__ATOMIC_RELEASE, "agent");
            asm volatile("s_waitcnt vmcnt(0)" ::: "memory");
            const unsigned og = xb_add(&bar[XB_TOP], 1u);
            const unsigned tg = og / nx;
            if (og + 1u == (tg + 1u) * nx) xb_add(&bar[XB_TOPGEN], 1u);
            else XB_SPIN(xb_ld(&bar[XB_TOPGEN]) == tg, bar);
            __builtin_amdgcn_fence(__ATOMIC_ACQUIRE, "agent");
            xb_add(&bar[XB_XGEN(b.x)], 1u);
            asm volatile("s_waitcnt vmcnt(0)" ::: "memory");
        } else {
            XB_SPIN(xb_ld(&bar[XB_XGEN(b.x)]) == gen, bar);
            __builtin_amdgcn_fence(__ATOMIC_ACQUIRE, "agent");
            asm volatile("s_waitcnt vmcnt(0)" ::: "memory");
        }
    }
    __syncthreads();
}


constexpr int NPHASE = 12;
__global__ void __launch_bounds__(512, 2) hymba_mega(Params P) {
    extern __shared__ __attribute__((aligned(16))) unsigned char shm[];
    cg::grid_group grid = cg::this_grid();
    unsigned char* ws = P.ws;
    volatile LAS unsigned* xst = (volatile LAS unsigned*)(LAS unsigned char*)(shm + LDS_STAGE);
    if (threadIdx.x == 0) { xst[0] = 0u; xst[1] = 0u; }
    __syncthreads();
    const XcdBarrier xb = xcd_barrier_post((unsigned*)(ws + OFF_BAR), xst);
#define GSYNC(k) do { if ((k) == 0 && P.one == 0) grid.sync(); xcd_barrier(xb); } while (0)
#ifndef DUPMASK
#define DUPMASK 0
#endif
#define RUN_PHASE(k, ...) if (P.ph_lo <= (k) && (k) < P.ph_hi) { \
        if (DUPMASK & (1 << (k))) { const int dry = P.one; __VA_ARGS__ GSYNC(k); } \
        { const int dry = 0; (void)dry; __VA_ARGS__ } \
        if ((k) + 1 < P.ph_hi) GSYNC(k); }
#define GEMM_PHASE(EPI, Aoff, Boff, M_, N_, K_, ...) { pg8::Gemm g{(const bf16_t*)(ws + (Aoff)), (const bf16_t*)(ws + (Boff)), (M_), (N_), (K_), (K_)}; pg8::StaticOrder so; so.init((M_), (N_), (int)gridDim.x, (int)blockIdx.x); \
        EPI e{__VA_ARGS__}; pg8::gemm_phase<EPI, pg8::StaticOrder, false>((PG8_LAS unsigned char*)shm, g, so, e, nullptr); }
    RUN_PHASE(0, phase_prep(P, shm);)
    RUN_PHASE(1, GEMM_PHASE(EpiBf16Scale, OFF_XB, OFF_WIN, S_, 8192, DM, (bf16_t*)(ws + OFF_PROJ), NINP, (const float*)(ws + OFF_RSTD0), 0))
    RUN_PHASE(2, phase_norm(P, shm);)
    RUN_PHASE(3, phase3(P, shm, dry);)
    RUN_PHASE(4, phase_cmp2(P, shm);)
    RUN_PHASE(5, cmp_slc_phase(P, shm, dry);)
    RUN_PHASE(8, GEMM_PHASE(EpiOutProj, OFF_ON, OFF_WOUT, S_, DM, DM, P.x, P.out, (bf16_t*)(ws + OFF_X1B), (float*)(ws + OFF_SS1), dry, (const float*)(ws + OFF_SSAB)))
    RUN_PHASE(9, GEMM_PHASE(EpiGateUp, OFF_X1B, OFF_WGU, S_, NGU, DM, (bf16_t*)(ws + OFF_HF), (const float*)(ws + OFF_SS1), P.conv_w, P.conv_b, (float*)(ws + OFF_STL), (float*)(ws + OFF_STG), (float*)(ws + OFF_STU), (LAS float*)((PG8_LAS unsigned char*)shm + 131072)))
    RUN_PHASE(10, phase_fixup(P, -1, (int)(blockIdx.x * 512 + threadIdx.x), (int)(gridDim.x * 512));)
    RUN_PHASE(11, GEMM_PHASE(EpiDown, OFF_HF, OFF_WD, S_, DM, DFF, P.out, dry))
}

extern "C" void kernel_launch(void* const* d_in, const int* in_sizes, int n_in, void* d_out, int out_size, void* d_ws, size_t ws_size, hipStream_t stream) {
    static int grid_blocks = 0;
    if (grid_blocks == 0) {
        if (n_in != 22 || out_size != S_ * DM || ws_size < WS_END) { fprintf(stderr, "kernel_launch: unexpected shapes (n_in %d out %d ws %zu need %zu)\n", n_in, out_size, ws_size, (size_t)WS_END); grid_blocks = -1; return; }
        int dev = 0, cus = 0, per_cu = 0;
        hipGetDevice(&dev); hipDeviceGetAttribute(&cus, hipDeviceAttributeMultiprocessorCount, dev);
        if (hipFuncSetAttribute((const void*)hymba_mega, hipFuncAttributeMaxDynamicSharedMemorySize, LDS_BYTES) != hipSuccess) { fprintf(stderr, "kernel_launch: hipFuncSetAttribute failed\n"); grid_blocks = -1; return; }
        if (hipOccupancyMaxActiveBlocksPerMultiprocessor(&per_cu, (const void*)hymba_mega, 512, LDS_BYTES) != hipSuccess || per_cu < 1) { fprintf(stderr, "kernel_launch: occupancy query failed (%d)\n", per_cu); (void)hipGetLastError(); per_cu = 1; }
        grid_blocks = cus * per_cu;
        if (grid_blocks < 128) { fprintf(stderr, "kernel_launch: this kernel needs >= 128 co-resident workgroups (got %d)\n", grid_blocks); grid_blocks = -1; return; }
    }
    if (grid_blocks < 0) return;
    Params P{};
    const float** pp = (const float**)&P;
    for (int i = 0; i < 22; ++i) pp[i] = (const float*)d_in[i];
    P.out = (float*)d_out; P.ws = (unsigned char*)d_ws; P.ph_lo = 0; P.ph_hi = NPHASE; P.one = 1;
    if (hipMemsetAsync((unsigned char*)d_ws + OFF_BAR, 0, XCD_BAR_WORDS * sizeof(unsigned), stream) != hipSuccess) { fprintf(stderr, "kernel_launch: memset failed\n"); return; }
    void* args[] = {&P};
    hipError_t e = hipLaunchCooperativeKernel((const void*)hymba_mega, dim3(grid_blocks), dim3(512), args, LDS_BYTES, stream);
    if (e != hipSuccess) fprintf(stderr, "cooperative launch failed: %s (grid %d)\n", hipGetErrorString(e), grid_blocks);
}
```

```cpp
#include <hip/hip_runtime.h>
#include <hip/hip_cooperative_groups.h>
#include <cstdio>
#include <cstdint>
namespace cg = cooperative_groups;
#include <type_traits>
namespace pg8 {
#define PG8_LAS __attribute__((address_space(3)))
typedef unsigned short bf16_t;
typedef short bf16x8 __attribute__((ext_vector_type(8)));
typedef float f32x4 __attribute__((ext_vector_type(4)));
typedef unsigned u32x4 __attribute__((ext_vector_type(4)));
constexpr int BM = 256, BK = 64, HALF = 128, HTB = HALF * BK * 2  , STAGE_BYTES = 8 * HTB, NXCD = 8, WGM = 8;

__host__ __device__ __forceinline__ int lds_byte(int r, int c) { const int st = (r >> 4) * 2 + (c >> 5), rr = r & 15, cc = c & 31, ob = rr * 64 + cc * 2; return st * 1024 + (ob ^ (((ob >> 9) & 1) << 5)); }
__host__ __device__ __forceinline__ void stage_rc(int b, int& R, int& C) { const int st = b / 1024, sb = b % 1024, swz = sb ^ (((sb >> 9) & 1) << 5); R = (st >> 1) * 16 + swz / 64; C = (st & 1) * 32 + (swz % 64) / 2; }
__host__ __device__ __forceinline__ int perm32(int rho) { const int n = rho >> 4, i = rho & 15; return 8 * (i >> 2) + 4 * n + (i & 3); }

struct Unit { int pm, pn; };
struct Gemm { const bf16_t* A; const bf16_t* Bt; int M, N, K, ld; };

struct StaticOrder {
    int nM, nN, nwg, G, c;
    __host__ __device__ void init(int M, int N, int G_, int c_) { nM = M / BM; nN = N / BM; nwg = nM * nN; G = G_; c = c_; }
    __host__ __device__ bool next(int i, Unit& u) const {
        const long L = (long)i * G + c; if (L >= nwg) return false;
        int wgid = (int)L; { const int q = nwg / NXCD, r = nwg % NXCD, xcd = wgid % NXCD, off = wgid / NXCD; wgid = (xcd < r ? xcd * (q + 1) : r * (q + 1) + (xcd - r) * q) + off; }
        const int nig = WGM * nN, gid = wgid / nig, fm = gid * WGM, gsz = (nM - fm) < WGM ? (nM - fm) : WGM;
        u.pm = fm + ((wgid % nig) % gsz); u.pn = (wgid % nig) / gsz; return true;
    }
    __device__ __forceinline__ void a_ready(const Unit&) const {}
    __device__ __forceinline__ void done(const Unit&) const {}
};
__device__ __forceinline__ unsigned cvt_pk_bf16(float lo, float hi) { unsigned r; asm volatile("v_cvt_pk_bf16_f32 %0, %1, %2" : "=v"(r) : "v"(lo), "v"(hi)); return r; }
template <class Epi, class Sched, bool STAMP = false>
__device__ __forceinline__ void gemm_phase(PG8_LAS unsigned char* lds, const Gemm g, const Sched& S, const Epi& E, unsigned long long* stamps) {
    const int tid = threadIdx.x, wid = __builtin_amdgcn_readfirstlane(tid >> 6), lane = tid & 63, wr = wid >> 2, wc = wid & 3, fr = lane & 15, fq = lane >> 4;
    const int K = g.ld, nt = g.K / BK;
    int ts_lo = 0, ts_hi = 0, nts = 0; const unsigned long long rt_entry = STAMP ? (unsigned long long)wall_clock64() : 0ull;
#define PG8_STAMP() do { if (STAMP && wid == 0 && nts < 64) { const unsigned long long _c = (unsigned long long)clock64(); \
        ts_lo = (lane == nts) ? (int)(unsigned)_c : ts_lo; ts_hi = (lane == nts) ? (int)(unsigned)(_c >> 32) : ts_hi; ++nts; } } while (0)
    PG8_STAMP();
    unsigned voffA[2], voffB[2];
#pragma unroll
    for (int i = 0; i < 2; ++i) { int R, C; stage_rc(tid * 16 + i * 8192, R, C); const int Rb = Epi::PERM ? ((R & ~31) + perm32(R & 31)) : R;
        voffA[i] = (unsigned)(R * K + C) * 2u; voffB[i] = (unsigned)(Rb * K + C) * 2u; }
    const size_t kstep = (size_t)(BK * 2);
    const size_t hstep = (size_t)HALF * K * 2;
    const size_t tstep = 2 * hstep;
    const unsigned ldsw = (unsigned)wid * 1024u;
    const int aoff = lds_byte(wr * 64 + fr, fq * 8), boff = lds_byte(wc * 32 + fr, fq * 8);
#define PG8_SA(b, h) (((b) * 2 + (h)) * HTB)
#define PG8_SB(b, h) ((4 + (b) * 2 + (h)) * HTB)
#define PG8_STAGE(bufoff, gbase, voff) do { _Pragma("unroll") for (int _i = 0; _i < 2; ++_i) \
        __builtin_amdgcn_global_load_lds((const unsigned*)((const char*)(gbase) + (voff)[_i]), (PG8_LAS unsigned*)(lds + (bufoff) + ldsw + _i * 8192), 16, 0, 0); } while (0)
#define PG8_LDA(dst, b, h) do { _Pragma("unroll") for (int m = 0; m < 4; ++m) _Pragma("unroll") for (int k = 0; k < 2; ++k) dst[m][k] = *(const PG8_LAS bf16x8*)(lds + PG8_SA(b, h) + aoff + m * 2048 + k * 1024); } while (0)
#define PG8_LDB(dst, b, h) do { _Pragma("unroll") for (int n = 0; n < 2; ++n) _Pragma("unroll") for (int k = 0; k < 2; ++k) dst[n][k] = *(const PG8_LAS bf16x8*)(lds + PG8_SB(b, h) + boff + n * 2048 + k * 1024); } while (0)
#define PG8_MMA(ai, bj, At, Bt) do { __builtin_amdgcn_s_setprio(1); _Pragma("unroll") for (int m = 0; m < 4; ++m) _Pragma("unroll") for (int n = 0; n < 2; ++n) _Pragma("unroll") for (int k = 0; k < 2; ++k) \
        acc[ai][bj][m][n] = __builtin_amdgcn_mfma_f32_16x16x32_bf16(Bt[n][k], At[m][k], acc[ai][bj][m][n], 0, 0, 0); __builtin_amdgcn_s_setprio(0); } while (0)
#define PG8_WAIT_V(n) asm volatile("s_waitcnt vmcnt(" #n ")" ::: "memory")
#define PG8_WAIT_L(n) asm volatile("s_waitcnt lgkmcnt(" #n ")" ::: "memory")
#define PG8_BAR __builtin_amdgcn_s_barrier()
#define PG8_SCHED __builtin_amdgcn_sched_barrier(0)
    Unit cur, nxt; int ui = 0;
    if (!S.next(0, cur)) return;
    f32x4 acc[2][2][4][2];
#pragma unroll
    for (int a = 0; a < 2; ++a)
#pragma unroll
        for (int b = 0; b < 2; ++b)
#pragma unroll
            for (int m = 0; m < 4; ++m)
#pragma unroll
                for (int n = 0; n < 2; ++n) acc[a][b][m][n] = (f32x4){0.f, 0.f, 0.f, 0.f};
    bf16x8 At[4][2], B0[2][2], B1[2][2];
    const char* cA = (const char*)g.A + (size_t)cur.pm * tstep; const char* cB = (const char*)g.Bt + (size_t)cur.pn * tstep;
    S.a_ready(cur);
    PG8_STAGE(PG8_SB(0, 0), cB, voffB); PG8_STAGE(PG8_SA(0, 0), cA, voffA); PG8_STAGE(PG8_SB(0, 1), cB + hstep, voffB); PG8_STAGE(PG8_SA(0, 1), cA + hstep, voffA);
    if (wr == 1) PG8_BAR;
    PG8_WAIT_V(4); PG8_BAR;
    PG8_STAGE(PG8_SB(1, 0), cB + kstep, voffB); PG8_STAGE(PG8_SA(1, 0), cA + kstep, voffA); PG8_STAGE(PG8_SB(1, 1), cB + hstep + kstep, voffB);
    PG8_WAIT_V(6); PG8_BAR;
    PG8_STAMP();
    for (;;) {
        const bool has_next = S.next(ui + 1, nxt);
        const char* nA = has_next ? (const char*)g.A + (size_t)nxt.pm * tstep : cA; const char* nB = has_next ? (const char*)g.Bt + (size_t)nxt.pn * tstep : cB;
        for (int t = 0; t < nt; t += 2) {
            const bool last = (t == nt - 2);
            if constexpr (Epi::MIDSCALE) { if (t == (nt >> 1)) E.mid(acc, cur, wr, wc, fr, fq); }
            const char* a1 = cA + (size_t)(t + 1) * kstep;
            const char* a2 = last ? nA : cA + (size_t)(t + 2) * kstep; const char* b2 = last ? nB : cB + (size_t)(t + 2) * kstep;
            const char* a3 = a2 + kstep; const char* b3 = b2 + kstep;
            if (last && has_next) S.a_ready(nxt);
            PG8_LDB(B0, 0, 0); PG8_SCHED; PG8_LDA(At, 0, 0); PG8_STAGE(PG8_SA(1, 1), a1 + hstep, voffA);
            PG8_WAIT_L(8); PG8_BAR; PG8_WAIT_L(0); PG8_MMA(0, 0, At, B0); PG8_BAR; PG8_SCHED;
            PG8_LDB(B1, 0, 1); PG8_STAGE(PG8_SB(0, 0), b2, voffB);
            PG8_BAR; PG8_WAIT_L(0); PG8_MMA(0, 1, At, B1); PG8_BAR;
            PG8_LDA(At, 0, 1); PG8_STAGE(PG8_SA(0, 0), a2, voffA);
            PG8_BAR; PG8_WAIT_L(0); PG8_MMA(1, 0, At, B0); PG8_BAR; PG8_SCHED;
            PG8_STAGE(PG8_SB(0, 1), b2 + hstep, voffB);
            PG8_WAIT_V(6); PG8_BAR; PG8_MMA(1, 1, At, B1); PG8_BAR;
            PG8_LDB(B0, 1, 0); PG8_SCHED; PG8_LDA(At, 1, 0); PG8_STAGE(PG8_SA(0, 1), a2 + hstep, voffA);
            PG8_WAIT_L(8); PG8_BAR; PG8_WAIT_L(0); PG8_MMA(0, 0, At, B0); PG8_BAR; PG8_SCHED;
            PG8_LDB(B1, 1, 1); PG8_STAGE(PG8_SB(1, 0), b3, voffB);
            PG8_BAR; PG8_WAIT_L(0); PG8_MMA(0, 1, At, B1); PG8_BAR;
            PG8_LDA(At, 1, 1); PG8_STAGE(PG8_SA(1, 0), a3, voffA);
            PG8_BAR; PG8_WAIT_L(0); PG8_MMA(1, 0, At, B0); PG8_BAR; PG8_SCHED;
            PG8_STAGE(PG8_SB(1, 1), b3 + hstep, voffB);
            PG8_WAIT_V(6); PG8_BAR; PG8_MMA(1, 1, At, B1); PG8_BAR;
        }
        PG8_STAMP();
        if constexpr (!Epi::AFTER_DRAIN) { E(acc, cur, wr, wc, fr, fq); S.done(cur); }
        PG8_STAMP();
        if (!has_next) break;
#pragma unroll
        for (int a = 0; a < 2; ++a)
#pragma unroll
            for (int b = 0; b < 2; ++b)
#pragma unroll
                for (int m = 0; m < 4; ++m)
#pragma unroll
                    for (int n = 0; n < 2; ++n) acc[a][b][m][n] = (f32x4){0.f, 0.f, 0.f, 0.f};
        cur = nxt; cA = nA; cB = nB; ++ui;
    }
    PG8_WAIT_V(0);
    if (wr == 0) PG8_BAR;
    PG8_BAR;
    if constexpr (Epi::AFTER_DRAIN) { E.fused(acc, cur, wr, wc, fr, fq, lds, wid, lane); S.done(cur); }
    PG8_STAMP();
    if (STAMP && wid == 0) { stamps[lane] = lane < nts ? (((unsigned long long)(unsigned)ts_hi << 32) | (unsigned)ts_lo) : 0ull;
        if (lane == 62) stamps[62] = rt_entry; if (lane == 63) stamps[63] = (unsigned long long)wall_clock64(); }
#undef PG8_STAMP
#undef PG8_SA
#undef PG8_SB
#undef PG8_STAGE
#undef PG8_LDA
#undef PG8_LDB
#undef PG8_MMA
#undef PG8_WAIT_V
#undef PG8_WAIT_L
#undef PG8_BAR
#undef PG8_SCHED
}
}

#define LAS __attribute__((address_space(3)))
typedef unsigned short bf16_t;
typedef short bf16x8 __attribute__((ext_vector_type(8)));
typedef float f32x4 __attribute__((ext_vector_type(4)));
typedef unsigned u32x4 __attribute__((ext_vector_type(4)));
typedef unsigned u32x2 __attribute__((ext_vector_type(2)));
using pg8::cvt_pk_bf16;

constexpr int S_ = 8192, DM = 4096, NIN = 8240, NINP = 8448, DFF = 11008, NGU = 22016;
constexpr float EPS_ = 1e-6f;
constexpr float LOG2E = 1.4426950408889634f;
constexpr float QSCALE = 0.08838834764831845f * 1.4426950408889634f;
constexpr int LDS_STAGE = 147456, LDS_BYTES = LDS_STAGE + 256;

constexpr size_t SZ_WGU = (size_t)NGU * DM * 2, SZ_WD = (size_t)DM * DFF * 2, SZ_WOUT = (size_t)DM * DM * 2, SZ_W1 = 512ull * 4096 * 2, SZ_SMALL = 1u << 20;
constexpr size_t OFF_WGU = 0, OFF_WD = OFF_WGU + SZ_WGU, OFF_WOUT = OFF_WD + SZ_WD, OFF_W1 = OFF_WOUT + SZ_WOUT, OFF_SMALL = OFF_W1 + SZ_W1;
constexpr size_t OFF_BAR = OFF_SMALL + 262144;
constexpr size_t OFF_SSAB = OFF_SMALL + 327680;
constexpr size_t OFF_MREF = OFF_SMALL + 197632;
constexpr size_t OFF_QCTR = OFF_SMALL + 196608;
constexpr size_t OFF_RSTD0 = OFF_SMALL, OFF_SS1 = OFF_SMALL + 32768, OFF_B1PART = OFF_SMALL + 65536, OFF_B1P = OFF_SMALL + 131072;
constexpr size_t OFF_C = OFF_SMALL + SZ_SMALL;
constexpr size_t SZ_Q = (size_t)S_ * 2048 * 2, SZ_KV = (size_t)S_ * 512 * 2;
constexpr size_t OFF_QA = OFF_C, OFF_QB = OFF_QA + SZ_Q, OFF_KA = OFF_QB + SZ_Q, OFF_KS = OFF_KA + SZ_KV, OFF_KW = OFF_KS + SZ_KV;
constexpr size_t OFF_VA = OFF_KW + SZ_KV, OFF_VS = OFF_VA + SZ_KV, OFF_VW = OFF_VS + SZ_KV;
constexpr size_t OFF_GATES = OFF_VW + SZ_KV, SZ_GATES = (size_t)S_ * 48 * 4;
constexpr size_t OFF_IM2 = OFF_GATES + SZ_GATES, SZ_IM2 = 4096ull * 4096 * 2;
constexpr size_t OFF_H = OFF_IM2 + SZ_IM2, SZ_H = 4096ull * 256 * 2;
constexpr size_t OFF_KC = OFF_H + SZ_H, SZ_KC = 4ull * 512 * 128 * 2;
constexpr size_t OFF_VCT = OFF_KC + SZ_KC;
constexpr size_t OFF_SEL = OFF_VCT + SZ_KC, SZ_SEL = 4ull * S_ * 16;
constexpr size_t OFF_B = OFF_SEL + SZ_SEL;
constexpr size_t SZ_WIN = (size_t)NINP * DM * 2, SZ_XB = (size_t)S_ * DM * 2, SZ_PROJ = (size_t)S_ * NINP * 2;
constexpr size_t OFF_WIN = OFF_B, OFF_XB = OFF_WIN + SZ_WIN, OFF_PROJ = OFF_XB + SZ_XB;
constexpr size_t OFF_HACC = OFF_PROJ + SZ_PROJ, SZ_HACC = 4096ull * 256 * 4;
constexpr size_t OFF_GACC = OFF_HACC + SZ_HACC, SZ_GACC = (size_t)S_ * 48 * 4;
constexpr size_t WS_END = OFF_GACC + SZ_GACC;
constexpr size_t OFF_GU = OFF_C, SZ_GU = (size_t)S_ * NGU * 2;
constexpr size_t OFF_X1B = OFF_PROJ + SZ_PROJ - SZ_XB;
constexpr size_t OFF_ON = OFF_WIN;
constexpr size_t SZ_STASH = 32ull * 2 * DFF * 4;
constexpr size_t OFF_STL = OFF_C, OFF_STG = OFF_STL + SZ_STASH, OFF_STU = OFF_STG + SZ_STASH;
constexpr size_t OFF_HF = OFF_C + (16u << 20);
static_assert(OFF_STU + SZ_STASH <= OFF_HF && OFF_HF + (size_t)S_ * DFF * 2 <= OFF_X1B, "h / stash placement");
static_assert(OFF_X1B >= OFF_GU + SZ_GU, "x1b overlaps GU");
static_assert(SZ_XB <= SZ_WIN, "o_n overlay");

struct Params {
    const float *x, *rel_bias, *norm_mix_g, *w_in, *a_q_g, *a_k_g, *a_sinks, *b_q_g, *b_k_g, *pos_emb, *cmp_w1, *cmp_b1, *cmp_w2, *cmp_b2,
        *out_norm_g, *w_out, *norm_ffn_g, *w_gate, *w_up, *conv_w, *conv_b, *w_down;
    float* out;
    unsigned char* ws;
    int ph_lo, ph_hi, one, pad_;
};

__device__ __forceinline__ float bf_lo(unsigned w) { return __uint_as_float(w << 16); }
__device__ __forceinline__ float bf_hi(unsigned w) { return __uint_as_float(w & 0xffff0000u); }
__device__ __forceinline__ float wave_sum(float v) {
#pragma unroll
    for (int o = 32; o >= 1; o >>= 1) v += __shfl_xor(v, o);
    return v;
}
__constant__ unsigned char T5B[132] = {0, 1, 2, 3, 4, 5, 6, 7, 8, 9, 10, 11, 12, 13, 14, 15, 16, 16, 16, 17, 17, 18, 18, 18, 19, 19, 19, 20, 20, 20, 20, 21, 21, 21, 21, 22, 22, 22, 22, 22, 23, 23, 23, 23, 23, 23, 24, 24, 24, 24, 24, 24, 25, 25, 25, 25, 25, 25, 25, 26, 26, 26, 26, 26, 26, 26, 26, 27, 27, 27, 27, 27, 27, 27, 27, 27, 27, 28, 28, 28, 28, 28, 28, 28, 28, 28, 28, 29, 29, 29, 29, 29, 29, 29, 29, 29, 29, 29, 29, 30, 30, 30, 30, 30, 30, 30, 30, 30, 30, 30, 30, 30, 30, 31, 31, 31, 31, 31, 31, 31, 31, 31, 31, 31, 31, 31, 31, 31, 31, 31, 31, 31};

struct EpiBf16Scale {
    static constexpr bool PERM = true, AFTER_DRAIN = false, MIDSCALE = false;
    bf16_t* O; int ldc; const float* rs; int mode;
    __device__ __forceinline__ void operator()(const f32x4 (&acc)[2][2][4][2], const pg8::Unit& u, int wr, int wc, int fr, int fq) const {
        const int row0 = u.pm * 256 + wr * 64 + fr, col0 = u.pn * 256 + wc * 32 + 8 * fq;
#pragma unroll
        for (int ai = 0; ai < 2; ++ai)
#pragma unroll
            for (int m = 0; m < 4; ++m) {
                const int row = row0 + ai * 128 + m * 16;
                float sc = rs[row]; if (mode) sc = rsqrtf(sc * (1.0f / 4096.0f) + EPS_);
                bf16_t* rowp = O + (size_t)row * ldc + col0;
#pragma unroll
                for (int bj = 0; bj < 2; ++bj) { const f32x4 v0 = acc[ai][bj][m][0] * sc, v1 = acc[ai][bj][m][1] * sc;
                    u32x4 w; w.x = cvt_pk_bf16(v0[0], v0[1]); w.y = cvt_pk_bf16(v0[2], v0[3]); w.z = cvt_pk_bf16(v1[0], v1[1]); w.w = cvt_pk_bf16(v1[2], v1[3]);
                    *(u32x4*)(rowp + bj * 128) = w; }
            }
    }
};
struct EpiCmp {
    static constexpr bool PERM = false, AFTER_DRAIN = false, MIDSCALE = false;
    float* Hacc;
    __device__ __forceinline__ void operator()(const f32x4 (&acc)[2][2][4][2], const pg8::Unit& u, int wr, int wc, int fr, int fq) const {
        if ((u.pm >> 3) != u.pn) return;
        const int row0 = u.pm * 256 + wr * 64 + fr, col0 = wc * 32 + 4 * fq;
#pragma unroll
        for (int ai = 0; ai < 2; ++ai)
#pragma unroll
            for (int m = 0; m < 4; ++m) { float* rp = Hacc + (size_t)(row0 + ai * 128 + m * 16) * 256 + col0;
#pragma unroll
                for (int bj = 0; bj < 2; ++bj)
#pragma unroll
                    for (int n = 0; n < 2; ++n)
#pragma unroll
                        for (int j = 0; j < 4; ++j) atomicAdd(rp + bj * 128 + n * 16 + j, acc[ai][bj][m][n][j]); }
    }
};
struct EpiGates {
    static constexpr bool PERM = false, AFTER_DRAIN = false, MIDSCALE = false;
    float* gacc; const float* rstd;
    __device__ __forceinline__ void operator()(const f32x4 (&acc)[2][2][4][2], const pg8::Unit& u, int wr, int wc, int fr, int fq) const {
        if (wc > 1) return;
        const int row0 = u.pm * 256 + wr * 64 + fr;
#pragma unroll
        for (int ai = 0; ai < 2; ++ai)
#pragma unroll
            for (int m = 0; m < 4; ++m) {
                const int row = row0 + ai * 128 + m * 16; const float sc = rstd[row];
#pragma unroll
                for (int n = 0; n < 2; ++n) { const int col = wc * 32 + n * 16 + 4 * fq;
                    if (col < 48) {
#pragma unroll
                        for (int j = 0; j < 4; ++j) atomicAdd(gacc + (size_t)row * 48 + col + j, acc[ai][0][m][n][j] * sc); } }
            }
    }
};
struct EpiGateUp {
    static constexpr bool PERM = true, AFTER_DRAIN = false, MIDSCALE = false;
    bf16_t* hf; const float* ss1; const float* conv_w; const float* conv_b; float* stL; float* stG; float* stU; LAS float* X;
    __device__ __forceinline__ void operator()(const f32x4 (&acc)[2][2][4][2], const pg8::Unit& u, int wr, int wc, int fr, int fq) const {
        const int rowb = u.pm * 256 + wr * 64 + fr, colL = wc * 32 + 8 * fq, colG = u.pn * 128 + colL;
        float sc[2][4];
#pragma unroll
        for (int ai = 0; ai < 2; ++ai)
#pragma unroll
            for (int m = 0; m < 4; ++m) sc[ai][m] = rsqrtf(ss1[rowb + ai * 128 + m * 16] * (1.0f / 4096.0f) + EPS_);
        if (fr >= 14) {
#pragma unroll
            for (int ai = 0; ai < 2; ++ai)
#pragma unroll
                for (int n = 0; n < 2; ++n) { const f32x4 g = acc[ai][0][3][n] * sc[ai][3];
                    *(LAS f32x4*)(X + (((ai * 2 + wr) * 2 + (fr - 14)) * 128) + colL + 4 * n) = g;
                    if (ai == 1 && wr == 1) *(f32x4*)(stL + ((size_t)u.pm * 2 + (fr - 14)) * DFF + colG + 4 * n) = g; }
        }
        if (fr < 2 && wr == 0) {
#pragma unroll
            for (int n = 0; n < 2; ++n) { *(f32x4*)(stG + ((size_t)u.pm * 2 + fr) * DFF + colG + 4 * n) = acc[0][0][0][n] * sc[0][0];
                                          *(f32x4*)(stU + ((size_t)u.pm * 2 + fr) * DFF + colG + 4 * n) = acc[0][1][0][n] * sc[0][0]; }
        }
        f32x4 cw0[2], cw1[2], cw2[2], ccb[2];
#pragma unroll
        for (int n = 0; n < 2; ++n) { cw0[n] = *(const f32x4*)(conv_w + colG + 4 * n); cw1[n] = *(const f32x4*)(conv_w + DFF + colG + 4 * n); cw2[n] = *(const f32x4*)(conv_w + 2 * DFF + colG + 4 * n); ccb[n] = *(const f32x4*)(conv_b + colG + 4 * n); }
        asm volatile("s_waitcnt lgkmcnt(0)" ::: "memory"); __builtin_amdgcn_s_barrier(); __builtin_amdgcn_s_barrier(); asm volatile("" ::: "memory");
#pragma unroll
        for (int ai = 0; ai < 2; ++ai) {
            const bool havepred = (wr == 1) || (ai == 1);
            const int pblk = (wr == 1) ? ai * 2 : 1;
            u32x2 hp[4][2];
#pragma unroll
            for (int n = 0; n < 2; ++n) {
                const f32x4 w0 = cw0[n], w1 = cw1[n], w2 = cw2[n], cb = ccb[n];
                f32x4 B62 = {0.f, 0.f, 0.f, 0.f}, B63 = {0.f, 0.f, 0.f, 0.f};
                if (havepred) { B62 = *(const LAS f32x4*)(X + (pblk * 2 + 0) * 128 + colL + 4 * n); B63 = *(const LAS f32x4*)(X + (pblk * 2 + 1) * 128 + colL + 4 * n); }
                f32x4 g[4], s1[4], s2[4];
#pragma unroll
                for (int m = 0; m < 4; ++m) g[m] = acc[ai][0][m][n] * sc[ai][m];
#pragma unroll
                for (int m = 0; m < 4; ++m)
#pragma unroll
                    for (int j = 0; j < 4; ++j) { const int gi = __float_as_int(g[m][j]); s1[m][j] = __int_as_float(__builtin_amdgcn_mov_dpp(gi, 0x121, 0xf, 0xf, false)); s2[m][j] = __int_as_float(__builtin_amdgcn_mov_dpp(gi, 0x122, 0xf, 0xf, false)); }
#pragma unroll
                for (int m = 0; m < 4; ++m) {
                    const f32x4 p1 = (fr >= 1) ? s1[m] : (m > 0 ? s1[m > 0 ? m - 1 : 0] : B63);
                    const f32x4 p2 = (fr >= 2) ? s2[m] : (m > 0 ? s2[m > 0 ? m - 1 : 0] : (fr == 1 ? B63 : B62));
                    const f32x4 uu = acc[ai][1][m][n] * sc[ai][m];
                    const f32x4 z = cb + w0 * p2 + w1 * p1 + w2 * g[m];
                    f32x4 hv;
#pragma unroll
                    for (int j = 0; j < 4; ++j) hv[j] = z[j] * __builtin_amdgcn_rcpf(1.0f + __expf(-z[j])) * uu[j];
                    hp[m][n].x = cvt_pk_bf16(hv[0], hv[1]); hp[m][n].y = cvt_pk_bf16(hv[2], hv[3]);
                }
            }
#pragma unroll
            for (int m = 0; m < 4; ++m) {
                const bool skip = (ai == 0) && (wr == 0) && (m == 0) && (fr < 2);
                if (!skip) { u32x4 w; w.x = hp[m][0].x; w.y = hp[m][0].y; w.z = hp[m][1].x; w.w = hp[m][1].y;
                    *(u32x4*)(hf + (size_t)(rowb + ai * 128 + m * 16) * DFF + colG) = w; }
            }
        }
    }
};
struct EpiOutProj {
    static constexpr bool PERM = false, AFTER_DRAIN = false, MIDSCALE = true;
    const float* x; float* out; bf16_t* x1b; float* ss1; int dry; const float* ssAB;
    __device__ __forceinline__ void mid(f32x4 (&acc)[2][2][4][2], const pg8::Unit& u, int wr, int wc, int fr, int fq) const {
        const int row0 = u.pm * 256 + wr * 64 + fr;
#pragma unroll
        for (int ai = 0; ai < 2; ++ai) {
            float2 s[4];
#pragma unroll
            for (int m = 0; m < 4; ++m) s[m] = *(const float2*)(ssAB + 2 * (row0 + ai * 128 + m * 16));
#pragma unroll
            for (int m = 0; m < 4; ++m) {
                const float r = rsqrtf(s[m].x * (1.0f / 2048.0f) + EPS_) * sqrtf(s[m].y * (1.0f / 2048.0f) + EPS_);
#pragma unroll
                for (int bj = 0; bj < 2; ++bj)
#pragma unroll
                    for (int n = 0; n < 2; ++n) acc[ai][bj][m][n] = acc[ai][bj][m][n] * r; }
            asm volatile("" ::: "memory");
        }
    }
    __device__ __forceinline__ void operator()(const f32x4 (&acc)[2][2][4][2], const pg8::Unit& u, int wr, int wc, int fr, int fq) const {
        if (dry) return;
        const int row0 = u.pm * 256 + wr * 64 + fr, col0 = u.pn * 256 + wc * 32 + 4 * fq;
#pragma unroll
        for (int ai = 0; ai < 2; ++ai)
#pragma unroll
            for (int mp = 0; mp < 4; mp += 2) {
                f32x4 xv[2][2][2]; float rB[2];
#pragma unroll
                for (int mm = 0; mm < 2; ++mm) { const int row = row0 + ai * 128 + (mp + mm) * 16; const size_t off = (size_t)row * DM + col0;
                    rB[mm] = ssAB[2 * row + 1];
#pragma unroll
                    for (int bj = 0; bj < 2; ++bj)
#pragma unroll
                        for (int n = 0; n < 2; ++n) xv[mm][bj][n] = *(const f32x4*)(x + off + bj * 128 + n * 16); }
#pragma unroll
                for (int mm = 0; mm < 2; ++mm) { const int m = mp + mm; const int row = row0 + ai * 128 + m * 16; const size_t off = (size_t)row * DM + col0; float ss = 0.f;
                    const float rb = rsqrtf(rB[mm] * (1.0f / 2048.0f) + EPS_);
#pragma unroll
                    for (int bj = 0; bj < 2; ++bj)
#pragma unroll
                        for (int n = 0; n < 2; ++n) { const f32x4 o = xv[mm][bj][n] + acc[ai][bj][m][n] * rb;
                            *(f32x4*)(out + off + bj * 128 + n * 16) = o;
                            u32x2 w; w.x = cvt_pk_bf16(o[0], o[1]); w.y = cvt_pk_bf16(o[2], o[3]); *(u32x2*)(x1b + off + bj * 128 + n * 16) = w;
                            ss += (o[0] * o[0] + o[1] * o[1]) + (o[2] * o[2] + o[3] * o[3]); }
                    ss += __shfl_xor(ss, 16); ss += __shfl_xor(ss, 32);
                    if (fq == 0) atomicAdd(ss1 + row, ss); }
            }
    }
};
struct EpiDown {
    static constexpr bool PERM = false, AFTER_DRAIN = false, MIDSCALE = false;
    float* out; int dry;
    __device__ __forceinline__ void operator()(const f32x4 (&acc)[2][2][4][2], const pg8::Unit& u, int wr, int wc, int fr, int fq) const {
        if (dry) return;
        const int row0 = u.pm * 256 + wr * 64 + fr, col0 = u.pn * 256 + wc * 32 + 4 * fq;
#pragma unroll
        for (int ai = 0; ai < 2; ++ai)
#pragma unroll
            for (int mp = 0; mp < 4; mp += 2) {
                f32x4 ov[2][2][2];
#pragma unroll
                for (int mm = 0; mm < 2; ++mm)
#pragma unroll
                    for (int bj = 0; bj < 2; ++bj)
#pragma unroll
                        for (int n = 0; n < 2; ++n) ov[mm][bj][n] = *(const f32x4*)(out + (size_t)(row0 + ai * 128 + (mp + mm) * 16) * DM + col0 + bj * 128 + n * 16);
#pragma unroll
                for (int mm = 0; mm < 2; ++mm)
#pragma unroll
                    for (int bj = 0; bj < 2; ++bj)
#pragma unroll
                        for (int n = 0; n < 2; ++n) *(f32x4*)(out + (size_t)(row0 + ai * 128 + (mp + mm) * 16) * DM + col0 + bj * 128 + n * 16) = ov[mm][bj][n] + acc[ai][bj][mp + mm][n];
            }
    }
};

struct TDesc { const float* src; const float* gain; bf16_t* dst; int K, N, kt, nt, drow0; };
struct TRegs { f32x4 a[2], b[2]; float ga[2], gb[2]; };
__device__ __forceinline__ void tconv_load(const TDesc& t, TRegs& r) {
    const int tid = threadIdx.x, n4 = (tid & 31) * 4, kp = tid >> 5, k0 = t.kt * 64, n0 = t.nt * 128;
#pragma unroll
    for (int i = 0; i < 2; ++i) {
        const int kk = 2 * (kp + 16 * i);
        r.a[i] = (f32x4){0.f, 0.f, 0.f, 0.f}; r.b[i] = (f32x4){0.f, 0.f, 0.f, 0.f};
        if (n0 + n4 < t.N) { r.a[i] = __builtin_nontemporal_load((const f32x4*)(t.src + (size_t)(k0 + kk) * t.N + n0 + n4)); r.b[i] = __builtin_nontemporal_load((const f32x4*)(t.src + (size_t)(k0 + kk + 1) * t.N + n0 + n4)); }
        r.ga[i] = t.gain ? t.gain[k0 + kk] : 1.0f; r.gb[i] = t.gain ? t.gain[k0 + kk + 1] : 1.0f;
    }
}
__device__ __forceinline__ void tconv_store(unsigned* ldsw, const TDesc& t, const TRegs& r) {
    const int tid = threadIdx.x, n4 = (tid & 31) * 4, kp = tid >> 5, k0 = t.kt * 64, n0 = t.nt * 128;
#pragma unroll
    for (int i = 0; i < 2; ++i) {
        const f32x4 a = r.a[i] * r.ga[i], b = r.b[i] * r.gb[i];
#pragma unroll
        for (int j = 0; j < 4; ++j) ldsw[(n4 + j) * 33 + kp + 16 * i] = cvt_pk_bf16(a[j], b[j]);
    }
    __syncthreads();
    const int n = tid >> 2, c = tid & 3;
    u32x4 w0, w1;
    w0.x = ldsw[n * 33 + c * 8 + 0]; w0.y = ldsw[n * 33 + c * 8 + 1]; w0.z = ldsw[n * 33 + c * 8 + 2]; w0.w = ldsw[n * 33 + c * 8 + 3];
    w1.x = ldsw[n * 33 + c * 8 + 4]; w1.y = ldsw[n * 33 + c * 8 + 5]; w1.z = ldsw[n * 33 + c * 8 + 6]; w1.w = ldsw[n * 33 + c * 8 + 7];
    bf16_t* dp = t.dst + (size_t)(t.drow0 + n) * t.K + k0 + c * 16;
    *(u32x4*)dp = w0; *(u32x4*)(dp + 8) = w1;
}

__device__ void phase_prep(const Params& P, unsigned char* shm) {
    unsigned* ldsw = (unsigned*)shm;
    unsigned char* ws = P.ws;
    const int tid = threadIdx.x, wid = tid >> 6, lane = tid & 63;
    if (blockIdx.x == 0 && tid == 0) *(unsigned*)(ws + OFF_QCTR) = 0u;
    for (size_t i = (size_t)blockIdx.x * 512 + tid; i < (SZ_HACC + SZ_GACC) / 16; i += (size_t)gridDim.x * 512) ((f32x4*)(ws + OFF_HACC))[i] = (f32x4){0.f, 0.f, 0.f, 0.f};
    if (blockIdx.x == 0 && wid == 1) {
        float aq = fmaxf(fabsf(P.a_q_g[lane]), fabsf(P.a_q_g[lane + 64])), ak = fmaxf(fabsf(P.a_k_g[lane]), fabsf(P.a_k_g[lane + 64]));
        float bq = fmaxf(fabsf(P.b_q_g[lane]), fabsf(P.b_q_g[lane + 64])), bk = 0.f, ta = 0.f, tb = 0.f;
        for (int i = lane; i < 384; i += 64) bk = fmaxf(bk, fabsf(P.b_k_g[i]));
        for (int i = lane; i < 1024; i += 64) { const float v = fabsf(P.rel_bias[i]); if ((i & 31) < 16) ta = fmaxf(ta, v); else tb = fmaxf(tb, v); }
        if (lane < 16) ta = fmaxf(ta, fabsf(P.a_sinks[lane]));
#pragma unroll
        for (int o = 32; o >= 1; o >>= 1) { aq = fmaxf(aq, __shfl_xor(aq, o)); ak = fmaxf(ak, __shfl_xor(ak, o)); bq = fmaxf(bq, __shfl_xor(bq, o)); bk = fmaxf(bk, __shfl_xor(bk, o)); ta = fmaxf(ta, __shfl_xor(ta, o)); tb = fmaxf(tb, __shfl_xor(tb, o)); }
        const float ra = 11.3137085f * LOG2E * aq * ak + LOG2E * ta + 1.0f, rb = 11.3137085f * LOG2E * bq * bk + LOG2E * tb + 1.0f;
        if (lane == 0) { float* mr = (float*)(ws + OFF_MREF); mr[0] = ra; mr[1] = rb; mr[2] = (ra < 60.0f && rb < 60.0f) ? 1.0f : 0.0f; }
    }
    for (int i = blockIdx.x * 512 + tid; i < S_; i += gridDim.x * 512) { ((float*)(ws + OFF_SS1))[i] = 0.f; ((float*)(ws + OFF_SSAB))[2 * i] = 0.f; ((float*)(ws + OFF_SSAB))[2 * i + 1] = 0.f; }
    for (int row = blockIdx.x * 8 + wid; row < S_; row += gridDim.x * 8) {
        const f32x4* xr = (const f32x4*)(P.x + (size_t)row * DM); bf16_t* xo = (bf16_t*)(ws + OFF_XB) + (size_t)row * DM; float ss = 0.f;
#pragma unroll 4
        for (int i = 0; i < 16; ++i) { const f32x4 v = xr[i * 64 + lane]; ss += (v[0] * v[0] + v[1] * v[1]) + (v[2] * v[2] + v[3] * v[3]);
            u32x2 w; w.x = cvt_pk_bf16(v[0], v[1]); w.y = cvt_pk_bf16(v[2], v[3]); *(u32x2*)(xo + (i * 64 + lane) * 4) = w; }
        ss = wave_sum(ss);
        if (lane == 0) ((float*)(ws + OFF_RSTD0))[row] = rsqrtf(ss * (1.0f / 4096.0f) + EPS_);
    }
    constexpr int J0 = 64 * 66, J1 = J0 + 64 * 32, J2 = J1 + 64 * 86, J3 = J2 + 64 * 86, J4 = J3 + 172 * 32, J5 = J4 + 128, J6 = J5 + 128;
    auto decode = [&](int it) -> TDesc {
        TDesc t;
        if (it < J0) { t = TDesc{P.w_in, P.norm_mix_g, (bf16_t*)(ws + OFF_WIN), 4096, NIN, it / 66, it % 66, (it % 66) * 128}; }
        else if (it < J1) { const int i = it - J0; t = TDesc{P.w_out, P.out_norm_g, (bf16_t*)(ws + OFF_WOUT), 4096, 4096, i / 32, i % 32, (i % 32) * 128}; }
        else if (it < J2) { const int i = it - J1; t = TDesc{P.w_gate, P.norm_ffn_g, (bf16_t*)(ws + OFF_WGU), 4096, DFF, i / 86, i % 86, (i % 86) * 256}; }
        else if (it < J3) { const int i = it - J2; t = TDesc{P.w_up, P.norm_ffn_g, (bf16_t*)(ws + OFF_WGU), 4096, DFF, i / 86, i % 86, (i % 86) * 256 + 128}; }
        else if (it < J4) { const int i = it - J3; t = TDesc{P.w_down, nullptr, (bf16_t*)(ws + OFF_WD), DFF, 4096, i / 32, i % 32, (i % 32) * 128}; }
        else if (it < J5) { const int i = it - J4; t = TDesc{P.cmp_w1, nullptr, (bf16_t*)(ws + OFF_W1), 4096, 256, i / 2, i % 2, (i % 2) * 128}; }
        else { const int i = it - J5; t = TDesc{P.cmp_w1 + 4096 * 256, nullptr, (bf16_t*)(ws + OFF_W1) + 256 * 4096, 4096, 256, i / 2, i % 2, (i % 2) * 128}; }
        return t;
    };
    {
        int it = blockIdx.x;
        if (it < J6) {
            TDesc tc = decode(it); TRegs rc; tconv_load(tc, rc); int par = 0;
            for (;;) {
                const int itn = it + gridDim.x; const bool more = itn < J6;
                TDesc tn = tc; TRegs rn = rc;
                if (more) { tn = decode(itn); tconv_load(tn, rn); }
                tconv_store(ldsw + par * (128 * 33), tc, rc); par ^= 1;
                if (!more) break;
                tc = tn; rc = rn; it = itn;
            }
        }
    }
}

__device__ __forceinline__ void norm_head(const bf16_t* src, bf16_t* dst, float g0, float g1, float scale, int lane) {
    const unsigned w = *(const unsigned*)(src + 2 * lane); float a = bf_lo(w), b = bf_hi(w);
    const float ss = wave_sum(a * a + b * b); const float r = rsqrtf(ss * (1.0f / 128.0f) + EPS_) * scale;
    *(unsigned*)(dst + 2 * lane) = cvt_pk_bf16(a * r * g0, b * r * g1);
}
__device__ void phase_norm(const Params& P, unsigned char* shm) {
    unsigned char* ws = P.ws; const bf16_t* proj = (const bf16_t*)(ws + OFF_PROJ);
    const int tid = threadIdx.x, wid = tid >> 6, lane = tid & 63;
    {
        bf16_t* T = (bf16_t*)shm;
        for (int it = blockIdx.x; it < 768; it += gridDim.x) {
            const int v = it >> 8, sb = it & 255, s0 = sb * 32;
            const int col = v == 0 ? 2560 : (v == 1 ? 6656 : 7680);
            bf16_t* dst = (bf16_t*)(ws + (v == 0 ? OFF_VA : (v == 1 ? OFF_VS : OFF_VW)));
#pragma unroll
            for (int i = 0; i < 4; ++i) { const int r = (tid >> 6) + 8 * i, ch = tid & 63;
                *(u32x4*)(T + r * 520 + ch * 8) = *(const u32x4*)(proj + (size_t)(s0 + r) * NINP + col + ch * 8); }
            __syncthreads();
#pragma unroll
            for (int k = 0; k < 4; ++k) { unsigned w[4];
#pragma unroll
                for (int e = 0; e < 4; ++e) w[e] = (unsigned)T[(8 * k + 2 * e) * 520 + tid] | ((unsigned)T[(8 * k + 2 * e + 1) * 520 + tid] << 16);
                u32x4 o; o.x = w[0]; o.y = w[1]; o.z = w[2]; o.w = w[3];
                *(u32x4*)(dst + (size_t)tid * S_ + s0 + 8 * k) = o; }
            __syncthreads();
        }
    }
    {
        const int sub = lane >> 4, e8 = (lane & 15) * 8;
        float gaq[8], gak[8], gbq[8], gks[8], gkw[8];
#pragma unroll
        for (int j = 0; j < 8; ++j) { gaq[j] = P.a_q_g[e8 + j] * QSCALE; gak[j] = P.a_k_g[e8 + j]; gbq[j] = P.b_q_g[e8 + j] * QSCALE; gks[j] = P.b_k_g[128 + e8 + j]; gkw[j] = P.b_k_g[256 + e8 + j]; }
        for (int s = blockIdx.x * 8 + wid; s < S_; s += gridDim.x * 8) {
            const bf16_t* pr = proj + (size_t)s * NINP;
#pragma unroll
            for (int grp = 0; grp < 11; ++grp) {
                const int scol = grp < 4 ? grp * 512 : (grp == 4 ? 2048 : (grp < 9 ? 3072 + (grp - 5) * 512 : (grp == 9 ? 6144 : 7168)));
                bf16_t* dst = grp < 4 ? (bf16_t*)(ws + OFF_QA) + (size_t)s * 2048 + grp * 512 : (grp == 4 ? (bf16_t*)(ws + OFF_KA) + (size_t)s * 512 :
                              (grp < 9 ? (bf16_t*)(ws + OFF_QB) + (size_t)s * 2048 + (grp - 5) * 512 : (grp == 9 ? (bf16_t*)(ws + OFF_KS) + (size_t)s * 512 : (bf16_t*)(ws + OFF_KW) + (size_t)s * 512)));
                const u32x4 w = *(const u32x4*)(pr + scol + sub * 128 + e8);
                float v[8]; v[0] = bf_lo(w.x); v[1] = bf_hi(w.x); v[2] = bf_lo(w.y); v[3] = bf_hi(w.y); v[4] = bf_lo(w.z); v[5] = bf_hi(w.z); v[6] = bf_lo(w.w); v[7] = bf_hi(w.w);
                float ss = ((v[0] * v[0] + v[1] * v[1]) + (v[2] * v[2] + v[3] * v[3])) + ((v[4] * v[4] + v[5] * v[5]) + (v[6] * v[6] + v[7] * v[7]));
                ss += __shfl_xor(ss, 8); ss += __shfl_xor(ss, 4); ss += __shfl_xor(ss, 2); ss += __shfl_xor(ss, 1);
                const float r = rsqrtf(ss * (1.0f / 128.0f) + EPS_);
                u32x4 o;
                if (grp < 4) { o.x = cvt_pk_bf16(v[0] * r * gaq[0], v[1] * r * gaq[1]); o.y = cvt_pk_bf16(v[2] * r * gaq[2], v[3] * r * gaq[3]); o.z = cvt_pk_bf16(v[4] * r * gaq[4], v[5] * r * gaq[5]); o.w = cvt_pk_bf16(v[6] * r * gaq[6], v[7] * r * gaq[7]); }
                else if (grp == 4) { o.x = cvt_pk_bf16(v[0] * r * gak[0], v[1] * r * gak[1]); o.y = cvt_pk_bf16(v[2] * r * gak[2], v[3] * r * gak[3]); o.z = cvt_pk_bf16(v[4] * r * gak[4], v[5] * r * gak[5]); o.w = cvt_pk_bf16(v[6] * r * gak[6], v[7] * r * gak[7]); }
                else if (grp < 9) { o.x = cvt_pk_bf16(v[0] * r * gbq[0], v[1] * r * gbq[1]); o.y = cvt_pk_bf16(v[2] * r * gbq[2], v[3] * r * gbq[3]); o.z = cvt_pk_bf16(v[4] * r * gbq[4], v[5] * r * gbq[5]); o.w = cvt_pk_bf16(v[6] * r * gbq[6], v[7] * r * gbq[7]); }
                else if (grp == 9) { o.x = cvt_pk_bf16(v[0] * r * gks[0], v[1] * r * gks[1]); o.y = cvt_pk_bf16(v[2] * r * gks[2], v[3] * r * gks[3]); o.z = cvt_pk_bf16(v[4] * r * gks[4], v[5] * r * gks[5]); o.w = cvt_pk_bf16(v[6] * r * gks[6], v[7] * r * gks[7]); }
                else { o.x = cvt_pk_bf16(v[0] * r * gkw[0], v[1] * r * gkw[1]); o.y = cvt_pk_bf16(v[2] * r * gkw[2], v[3] * r * gkw[3]); o.z = cvt_pk_bf16(v[4] * r * gkw[4], v[5] * r * gkw[5]); o.w = cvt_pk_bf16(v[6] * r * gkw[6], v[7] * r * gkw[7]); }
                *(u32x4*)(dst + sub * 128 + e8) = o;
            }
        }
    }
    {
        bf16_t* im = (bf16_t*)(ws + OFF_IM2);
        for (int r = blockIdx.x * 8 + wid; r < 4096; r += gridDim.x * 8) {
            const int c = r >> 11, g = (r >> 9) & 3, n = r & 511, colc = (c ? 5632 : 5120) + g * 128;
            const int sub = lane >> 4, ch = lane & 15;
#pragma unroll
            for (int itx = 0; itx < 8; ++itx) { const int l = itx * 4 + sub; u32x4 v = {0u, 0u, 0u, 0u};
                if (n < 511) { const u32x4 t = *(const u32x4*)(proj + (size_t)(16 * n + l) * NINP + colc + ch * 8);
                    const f32x4 p0 = *(const f32x4*)(P.pos_emb + (size_t)c * 4096 + l * 128 + ch * 8), p1 = *(const f32x4*)(P.pos_emb + (size_t)c * 4096 + l * 128 + ch * 8 + 4);
                    v.x = cvt_pk_bf16(bf_lo(t.x) + p0[0], bf_hi(t.x) + p0[1]); v.y = cvt_pk_bf16(bf_lo(t.y) + p0[2], bf_hi(t.y) + p0[3]);
                    v.z = cvt_pk_bf16(bf_lo(t.z) + p1[0], bf_hi(t.z) + p1[1]); v.w = cvt_pk_bf16(bf_lo(t.w) + p1[2], bf_hi(t.w) + p1[3]); }
                *(u32x4*)(im + (size_t)r * 4096 + l * 128 + ch * 8) = v; }
        }
    }
}

__device__ void phase_cmp2(const Params& P, unsigned char* shm) {
    unsigned char* ws = P.ws; const int tid = threadIdx.x, wid = tid >> 6, lane = tid & 63;
    const float* Hacc = (const float*)(ws + OFF_HACC);
    float* hl = (float*)shm + wid * 512;
    for (int rp = blockIdx.x * 8 + wid; rp < 2048; rp += gridDim.x * 8) {
        const int r = rp * 2, c = r >> 11, g = (r >> 9) & 3, n = r & 511;
        const f32x4 bb = *(const f32x4*)(P.cmp_b1 + c * 256 + 4 * lane);
#pragma unroll
        for (int rr = 0; rr < 2; ++rr) { f32x4 v = *(const f32x4*)(Hacc + (size_t)(r + rr) * 256 + 4 * lane) + bb;
#pragma unroll
            for (int j = 0; j < 4; ++j) { const float a = v[j]; v[j] = __uint_as_float(cvt_pk_bf16(a * __builtin_amdgcn_rcpf(1.0f + __expf(-1.5957691216057308f * (a + 0.044715f * a * a * a))), 0.f) << 16); }
            *(f32x4*)(hl + rr * 256 + 4 * lane) = v; }
        const float* w2 = P.cmp_w2 + (size_t)c * 256 * 128 + 2 * lane;
        float a0 = P.cmp_b2[c * 128 + 2 * lane], a1 = P.cmp_b2[c * 128 + 2 * lane + 1], b0 = a0, b1 = a1;
#pragma unroll 8
        for (int k = 0; k < 256; ++k) { const float h0 = hl[k], h1 = hl[256 + k];
            const float2 w = *(const float2*)(w2 + (size_t)k * 128); a0 += h0 * w.x; a1 += h0 * w.y; b0 += h1 * w.x; b1 += h1 * w.y; }
        if (c == 0) {
            const float gk0 = P.b_k_g[2 * lane], gk1 = P.b_k_g[2 * lane + 1];
            const float ra = rsqrtf(wave_sum(a0 * a0 + a1 * a1) * (1.0f / 128.0f) + EPS_), rb = rsqrtf(wave_sum(b0 * b0 + b1 * b1) * (1.0f / 128.0f) + EPS_);
            bf16_t* kc = (bf16_t*)(ws + OFF_KC) + ((size_t)g * 512 + n) * 128 + 2 * lane;
            *(unsigned*)kc = cvt_pk_bf16(a0 * ra * gk0, a1 * ra * gk1); *(unsigned*)(kc + 128) = cvt_pk_bf16(b0 * rb * gk0, b1 * rb * gk1);
        } else {
            bf16_t* vt = (bf16_t*)(ws + OFF_VCT) + ((size_t)g * 128 + 2 * lane) * 512 + n;
            *(unsigned*)vt = cvt_pk_bf16(a0, b0); *(unsigned*)(vt + 512) = cvt_pk_bf16(a1, b1);
        }
    }
}

constexpr int AL_K = 0, AL_V = 16384, AL_BUF = 32768, AL_BIAS = 65536, AL_SC = 67840, AL_FS = 133376;
#define NEG_INF (-__builtin_inff())

template <int MODE, int PASS>
__device__ __forceinline__ void attn_tiles(unsigned char* shm, const bf16_t* kbase, int kstride, const bf16_t* vbase, int vstride, int kt_lo, int kt_hi,
                                           const bf16x8 (&qf)[2][4], float (&m_)[2], float (&l_)[2], const float (&inv2)[2], f32x4 (&O)[2][8],
                                           unsigned sm0, unsigned sm1, unsigned sm2, unsigned sm3, int query, int hp, int qs, int qlo, int hb0, int hb1, bool stats3) {
    const bool stats = (MODE != 2) && stats3;
    constexpr bool FIX = (MODE != 2) && (PASS == 0);
    const int tid = threadIdx.x, lane = tid & 63, n = lane & 15, qq = lane >> 4;
    const float* biasL = (const float*)(shm + AL_BIAS);
    const float bfar0 = biasL[hb0 * 132 + 128], bfar1 = biasL[hb1 * 132 + 128];
    float carry = 0.f;
    const int wid_ = __builtin_amdgcn_readfirstlane(tid >> 6);
    PG8_LAS unsigned char* shmL = (PG8_LAS unsigned char*)shm;
#define ATT_DMA(KT, B) do { const int key0_ = (KT) * 64; _Pragma("unroll") for (int i = 0; i < 2; ++i) { const int ci = wid_ * 2 + i; \
        const int r_ = 4 * ci + (lane >> 4), c_ = (lane & 15) ^ (r_ & 15); \
        __builtin_amdgcn_global_load_lds((const unsigned*)(kbase + (size_t)(key0_ + r_) * kstride + c_ * 8), (PG8_LAS unsigned*)(shmL + (B) * AL_BUF + AL_K + ci * 1024), 16, 0, 0); \
        const int d_ = 8 * ci + (lane >> 3), s_ = (lane & 7) ^ ((d_ >> 1) & 7); \
        __builtin_amdgcn_global_load_lds((const unsigned*)(vbase + (size_t)d_ * vstride + key0_ + s_ * 8), (PG8_LAS unsigned*)(shmL + (B) * AL_BUF + AL_V + ci * 1024), 16, 0, 0); } } while (0)
    ATT_DMA(kt_lo, 0);
    asm volatile("s_waitcnt vmcnt(0)" ::: "memory");
    __syncthreads();
#pragma unroll 1
    for (int kt = kt_lo; kt <= kt_hi; ++kt) {
        const int cur = (kt - kt_lo) & 1;
        if (kt < kt_hi) ATT_DMA(kt + 1, cur ^ 1);
        const unsigned char* kl = shm + cur * AL_BUF + AL_K; const unsigned char* vl = shm + cur * AL_BUF + AL_V;
        const int key0 = kt * 64;
        bool selb = true;
        if (MODE == 3) { const unsigned w = kt < 32 ? sm0 : (kt < 64 ? sm1 : (kt < 96 ? sm2 : sm3)); selb = (w >> (kt & 31)) & 1u; }
        bool doit = true;
        if (MODE == 3) doit = __ballot(selb) != 0ull;
        if (doit) {
            f32x4 Sx[2][4];
#pragma unroll
            for (int tq = 0; tq < 2; ++tq)
#pragma unroll
                for (int st = 0; st < 4; ++st) Sx[tq][st] = (f32x4){0.f, 0.f, 0.f, 0.f};
#pragma unroll
            for (int st = 0; st < 4; ++st)
#pragma unroll
                for (int dc = 0; dc < 4; ++dc) {
                    const bf16x8 kf = *(const bf16x8*)(kl + (st * 16 + n) * 256 + (((dc * 4 + qq) ^ n) * 16));
                    Sx[0][st] = __builtin_amdgcn_mfma_f32_16x16x32_bf16(kf, qf[0][dc], Sx[0][st], 0, 0, 0);
                    Sx[1][st] = __builtin_amdgcn_mfma_f32_16x16x32_bf16(kf, qf[1][dc], Sx[1][st], 0, 0, 0);
                }
            const int dmin = (MODE == 2) ? qlo - (16 * (key0 + 63) + 31) : qlo - (key0 + 63);
            const int dmax = (MODE == 2) ? qlo + 15 - (16 * key0 + 31) : qlo + 15 - key0;
            const bool fast = (MODE != 0) && dmin >= 128 && (MODE != 1 || dmax < 512);
            if (fast) {
#pragma unroll
                for (int tq = 0; tq < 2; ++tq) {
                    const float bc = tq ? bfar1 : bfar0;
                    if (FIX && stats) {
                        float tm = fmaxf(fmaxf(fmaxf(Sx[tq][0][0], Sx[tq][0][1]), fmaxf(Sx[tq][0][2], Sx[tq][0][3])), fmaxf(fmaxf(Sx[tq][1][0], Sx[tq][1][1]), fmaxf(Sx[tq][1][2], Sx[tq][1][3])));
                        tm = fmaxf(tm, fmaxf(fmaxf(fmaxf(Sx[tq][2][0], Sx[tq][2][1]), fmaxf(Sx[tq][2][2], Sx[tq][2][3])), fmaxf(fmaxf(Sx[tq][3][0], Sx[tq][3][1]), fmaxf(Sx[tq][3][2], Sx[tq][3][3]))));
                        tm = (MODE == 3 && !selb) ? NEG_INF : tm + bc;
                        tm = fmaxf(tm, __shfl_xor(tm, 16)); tm = fmaxf(tm, __shfl_xor(tm, 32));
                        m_[tq] = fmaxf(m_[tq], tm);
                    } else if ((PASS != 2 && FIX) || (MODE == 2 && PASS == 1 && stats3)) {
                        const float cc = (MODE == 3 && !selb) ? NEG_INF : bc - m_[tq];
                        float ps = 0.f;
#pragma unroll
                        for (int st = 0; st < 4; ++st)
#pragma unroll
                            for (int r = 0; r < 4; ++r) { const float p = __builtin_amdgcn_exp2f(Sx[tq][st][r] + cc); Sx[tq][st][r] = p; ps += p; }
                        l_[tq] += ps;
                    } else if (PASS != 2) {
                        float tm = fmaxf(fmaxf(fmaxf(Sx[tq][0][0], Sx[tq][0][1]), fmaxf(Sx[tq][0][2], Sx[tq][0][3])), fmaxf(fmaxf(Sx[tq][1][0], Sx[tq][1][1]), fmaxf(Sx[tq][1][2], Sx[tq][1][3])));
                        tm = fmaxf(tm, fmaxf(fmaxf(fmaxf(Sx[tq][2][0], Sx[tq][2][1]), fmaxf(Sx[tq][2][2], Sx[tq][2][3])), fmaxf(fmaxf(Sx[tq][3][0], Sx[tq][3][1]), fmaxf(Sx[tq][3][2], Sx[tq][3][3]))));
                        tm = (MODE == 3 && !selb) ? NEG_INF : tm + bc;
                        tm = fmaxf(tm, __shfl_xor(tm, 16)); tm = fmaxf(tm, __shfl_xor(tm, 32));
                        const float mn = fmaxf(m_[tq], tm), mu = (mn == NEG_INF) ? 0.f : mn;
                        const float alpha = __builtin_amdgcn_exp2f(m_[tq] - mu);
                        m_[tq] = mn;
                        const float cc = (MODE == 3 && !selb) ? NEG_INF : bc - mu;
                        float ps = 0.f;
#pragma unroll
                        for (int st = 0; st < 4; ++st)
#pragma unroll
                            for (int r = 0; r < 4; ++r) { const float p = __builtin_amdgcn_exp2f(Sx[tq][st][r] + cc); Sx[tq][st][r] = p; ps += p; }
                        l_[tq] = l_[tq] * alpha + ps;
                        if (PASS == 0) { if (__ballot(alpha != 1.0f) != 0ull) {
#pragma unroll
                            for (int dt = 0; dt < 8; ++dt) O[tq][dt] = O[tq][dt] * alpha; } }
                    } else {
                        const float mu = (m_[tq] == NEG_INF) ? 0.f : m_[tq]; const float cc = bc - mu;
#pragma unroll
                        for (int st = 0; st < 4; ++st)
#pragma unroll
                            for (int r = 0; r < 4; ++r) Sx[tq][st][r] = __builtin_amdgcn_exp2f(Sx[tq][st][r] + cc) * inv2[tq];
                    }
                }
            } else {
#pragma unroll
                for (int st = 0; st < 4; ++st)
#pragma unroll
                    for (int r = 0; r < 4; ++r) {
                        const int key = key0 + st * 16 + qq * 4 + r;
                        const int dist = (MODE == 2) ? query - (16 * key + 31) : query - key;
                        bool valid = dist >= 0;
                        if (MODE == 0) valid = valid && dist < 128;
                        if (MODE == 1) valid = valid && dist < 512;
                        if (MODE == 3) valid = valid && selb;
                        int idx = dist < 0 ? 0 : dist; idx = idx > 128 ? 128 : idx;
                        const float b0 = biasL[hb0 * 132 + idx], b1 = biasL[hb1 * 132 + idx];
                        Sx[0][st][r] = valid ? Sx[0][st][r] + b0 : NEG_INF;
                        Sx[1][st][r] = valid ? Sx[1][st][r] + b1 : NEG_INF;
                    }
#pragma unroll
                for (int tq = 0; tq < 2; ++tq) {
                    if (FIX && stats) {
                        float tm = NEG_INF;
#pragma unroll
                        for (int st = 0; st < 4; ++st)
#pragma unroll
                            for (int r = 0; r < 4; ++r) tm = fmaxf(tm, Sx[tq][st][r]);
                        tm = fmaxf(tm, __shfl_xor(tm, 16)); tm = fmaxf(tm, __shfl_xor(tm, 32));
                        m_[tq] = fmaxf(m_[tq], tm);
                    } else if ((PASS != 2 && FIX) || (MODE == 2 && PASS == 1 && stats3)) {
                        float ps = 0.f;
#pragma unroll
                        for (int st = 0; st < 4; ++st)
#pragma unroll
                            for (int r = 0; r < 4; ++r) { const float p = __builtin_amdgcn_exp2f(Sx[tq][st][r] - m_[tq]); Sx[tq][st][r] = p; ps += p; }
                        l_[tq] += ps;
                    } else if (PASS != 2) {
                        float tm = NEG_INF;
#pragma unroll
                        for (int st = 0; st < 4; ++st)
#pragma unroll
                            for (int r = 0; r < 4; ++r) tm = fmaxf(tm, Sx[tq][st][r]);
                        tm = fmaxf(tm, __shfl_xor(tm, 16)); tm = fmaxf(tm, __shfl_xor(tm, 32));
                        const float mn = fmaxf(m_[tq], tm), mu = (mn == NEG_INF) ? 0.f : mn;
                        const float alpha = __builtin_amdgcn_exp2f(m_[tq] - mu);
                        m_[tq] = mn;
                        float ps = 0.f;
#pragma unroll
                        for (int st = 0; st < 4; ++st)
#pragma unroll
                            for (int r = 0; r < 4; ++r) { const float p = __builtin_amdgcn_exp2f(Sx[tq][st][r] - mu); Sx[tq][st][r] = p; ps += p; }
                        l_[tq] = l_[tq] * alpha + ps;
                        if (PASS == 0) {
#pragma unroll
                            for (int dt = 0; dt < 8; ++dt) O[tq][dt] = O[tq][dt] * alpha;
                        }
                    } else {
                        const float mu = (m_[tq] == NEG_INF) ? 0.f : m_[tq];
#pragma unroll
                        for (int st = 0; st < 4; ++st)
#pragma unroll
                            for (int r = 0; r < 4; ++r) Sx[tq][st][r] = __builtin_amdgcn_exp2f(Sx[tq][st][r] - mu) * inv2[tq];
                    }
                }
            }
            if (PASS == 2) {
                float* scL = (float*)(shm + AL_SC) + hp * 128 * 64 + qs * 16 + n;
                float yprev = carry;
#pragma unroll
                for (int st = 0; st < 4; ++st) {
                    const float a = ((Sx[0][st][0] + Sx[0][st][1]) + (Sx[0][st][2] + Sx[0][st][3])) + ((Sx[1][st][0] + Sx[1][st][1]) + (Sx[1][st][2] + Sx[1][st][3]));
                    const float y = __shfl(Sx[0][st][3] + Sx[1][st][3], (lane + 48) & 63);
                    scL[(16 * kt + 4 * st + qq) * 64] = a + ((qq > 0) ? y : yprev);
                    yprev = y;
                }
                carry = yprev;
            }
            if (PASS != 1 && !stats) {
                bf16x8 pb[2][2];
#pragma unroll
                for (int tq = 0; tq < 2; ++tq)
#pragma unroll
                    for (int ch = 0; ch < 2; ++ch) { u32x4 w; w.x = cvt_pk_bf16(Sx[tq][2 * ch][0], Sx[tq][2 * ch][1]); w.y = cvt_pk_bf16(Sx[tq][2 * ch][2], Sx[tq][2 * ch][3]);
                        w.z = cvt_pk_bf16(Sx[tq][2 * ch + 1][0], Sx[tq][2 * ch + 1][1]); w.w = cvt_pk_bf16(Sx[tq][2 * ch + 1][2], Sx[tq][2 * ch + 1][3]); pb[tq][ch] = __builtin_bit_cast(bf16x8, w); }
#pragma unroll
                for (int dt = 0; dt < 8; ++dt)
#pragma unroll
                    for (int ch = 0; ch < 2; ++ch) {
                        const unsigned char* vp = vl + (dt * 16 + n) * 128 + (qq & 1) * 8;
                        const u32x2 lo = *(const u32x2*)(vp + (((4 * ch + (qq >> 1)) ^ (n >> 1)) * 16)), hi = *(const u32x2*)(vp + (((4 * ch + 2 + (qq >> 1)) ^ (n >> 1)) * 16));
                        u32x4 vv; vv.x = lo.x; vv.y = lo.y; vv.z = hi.x; vv.w = hi.y;
                        const bf16x8 vf = __builtin_bit_cast(bf16x8, vv);
                        O[0][dt] = __builtin_amdgcn_mfma_f32_16x16x32_bf16(vf, pb[0][ch], O[0][dt], 0, 0, 0);
                        O[1][dt] = __builtin_amdgcn_mfma_f32_16x16x32_bf16(vf, pb[1][ch], O[1][dt], 0, 0, 0);
                    }
            }
        }
        asm volatile("s_waitcnt vmcnt(0)" ::: "memory");
        __syncthreads();
    }
#undef ATT_DMA
}

template <int MODE>
__device__ void attn_item(const Params& P, unsigned char* shm, int qb, int g, int dry, bool refill = true) {
    unsigned char* ws = P.ws;
    const int tid = threadIdx.x, wid = tid >> 6, lane = tid & 63, n = lane & 15, qq = lane >> 4;
    const int qs = wid >> 1, hp = wid & 1;
    const int s0 = qb * 64, query = (MODE == 3) ? s0 + wid * 8 + (n >> 1) : s0 + qs * 16 + n;
    const int hb0 = (MODE == 3) ? (n & 1) : 2 * hp, hb1 = (MODE == 3) ? 2 + (n & 1) : 2 * hp + 1;
    const int qlo = (MODE == 3) ? s0 + wid * 8 : s0 + qs * 16;
    const bf16_t* qbuf = (const bf16_t*)(ws + (MODE == 0 ? OFF_QA : OFF_QB));
    const bf16_t* kbase; const bf16_t* vbase; int kstride, vstride;
    if (MODE == 0) { kbase = (const bf16_t*)(ws + OFF_KA) + g * 128; kstride = 512; vbase = (const bf16_t*)(ws + OFF_VA) + (size_t)g * 128 * S_; vstride = S_; }
    else if (MODE == 1) { kbase = (const bf16_t*)(ws + OFF_KW) + g * 128; kstride = 512; vbase = (const bf16_t*)(ws + OFF_VW) + (size_t)g * 128 * S_; vstride = S_; }
    else if (MODE == 3) { kbase = (const bf16_t*)(ws + OFF_KS) + g * 128; kstride = 512; vbase = (const bf16_t*)(ws + OFF_VS) + (size_t)g * 128 * S_; vstride = S_; }
    else { kbase = (const bf16_t*)(ws + OFF_KC) + (size_t)g * 512 * 128; kstride = 128; vbase = (const bf16_t*)(ws + OFF_VCT) + (size_t)g * 128 * 512; vstride = 512; }
    const int hbase = g * 4;
    float* biasL = (float*)(shm + AL_BIAS);
    __syncthreads();
    if (refill) {
        for (int i = tid; i < 4 * 129; i += 512) { const int hh = i / 129, d = i - hh * 129; biasL[hh * 132 + d] = P.rel_bias[(int)T5B[d] * 32 + (MODE == 0 ? 0 : 16) + g * 4 + hh] * LOG2E; }
        __syncthreads();
    }
    bf16x8 qf[2][4];
#pragma unroll
    for (int tq = 0; tq < 2; ++tq)
#pragma unroll
        for (int dc = 0; dc < 4; ++dc) qf[tq][dc] = *(const bf16x8*)(qbuf + (size_t)query * 2048 + (hbase + (tq ? hb1 : hb0)) * 128 + dc * 32 + qq * 8);
    const float mref = ((const float*)(ws + OFF_MREF))[MODE == 0 ? 0 : 1]; const bool fixok = ((const float*)(ws + OFF_MREF))[2] != 0.f; const bool fix = (MODE != 2) && fixok;
    float m_[2], l_[2];
#pragma unroll
    for (int tq = 0; tq < 2; ++tq) {
        if (fix || (MODE == 2 && fixok)) { m_[tq] = mref; l_[tq] = (MODE == 0 && qq == 0) ? __builtin_amdgcn_exp2f(P.a_sinks[hbase + (tq ? hb1 : hb0)] * LOG2E - mref) : 0.0f; }
        else if (MODE == 0) { m_[tq] = P.a_sinks[hbase + (tq ? hb1 : hb0)] * LOG2E; l_[tq] = qq == 0 ? 1.0f : 0.0f; } else { m_[tq] = NEG_INF; l_[tq] = 0.f; } }
    unsigned sm0 = 0, sm1 = 0, sm2 = 0, sm3 = 0;
    if (MODE == 3) { const u32x4 w = *(const u32x4*)((const unsigned*)(ws + OFF_SEL) + ((size_t)g * S_ + query) * 4); sm0 = w.x; sm1 = w.y; sm2 = w.z; sm3 = w.w; }
    int kt_lo, kt_hi;
    if (MODE == 0) { kt_lo = qb - 2 < 0 ? 0 : qb - 2; kt_hi = qb; }
    else if (MODE == 1) { kt_lo = qb - 8 < 0 ? 0 : qb - 8; kt_hi = qb; }
    else if (MODE == 2) { kt_lo = 0; kt_hi = qb >> 4; }
    else { kt_lo = 0; kt_hi = qb; }
    float inv2[2] = {1.f, 1.f};
    f32x4 O[2][8];
    __builtin_amdgcn_s_waitcnt(0);
    if (MODE == 2) {
        attn_tiles<MODE, 1>(shm, kbase, kstride, vbase, vstride, kt_lo, kt_hi, qf, m_, l_, inv2, O, sm0, sm1, sm2, sm3, query, hp, qs, qlo, hb0, hb1, fixok);
#pragma unroll
        for (int tq = 0; tq < 2; ++tq) { float l = l_[tq]; l += __shfl_xor(l, 16); l += __shfl_xor(l, 32); inv2[tq] = l > 0.f ? 1.0f / l : 0.f; }
    }
#pragma unroll
    for (int tq = 0; tq < 2; ++tq)
#pragma unroll
        for (int dt = 0; dt < 8; ++dt) O[tq][dt] = (f32x4){0.f, 0.f, 0.f, 0.f};
#pragma unroll 1
    for (int sweep = (MODE != 2 && !fix) ? 0 : 1; sweep < 2; ++sweep) {
        if (MODE == 0 && sweep == 1 && !fix) {
#pragma unroll
            for (int tq = 0; tq < 2; ++tq) l_[tq] = qq == 0 ? __builtin_amdgcn_exp2f(P.a_sinks[hbase + (tq ? hb1 : hb0)] * LOG2E - m_[tq]) : 0.0f; }
        attn_tiles<MODE, (MODE == 2 ? 2 : 0)>(shm, kbase, kstride, vbase, vstride, kt_lo, kt_hi, qf, m_, l_, inv2, O, sm0, sm1, sm2, sm3, query, hp, qs, qlo, hb0, hb1, sweep == 0); }
    float* obuf = P.out;
    bf16_t* onb = (bf16_t*)(ws + OFF_ON);
    float ssq = 0.f;
    if (!(MODE >= 2 && dry))
#pragma unroll
    for (int tq = 0; tq < 2; ++tq) {
        float sc;
        if (MODE == 2) sc = 1.0f;
        else { float l = l_[tq]; l += __shfl_xor(l, 16); l += __shfl_xor(l, 32); sc = l > 0.f ? 1.0f / l : 0.f; }
        const int h = hbase + (tq ? hb1 : hb0);
        float gold = 1.0f;
        if (MODE >= 2) sc *= __builtin_amdgcn_rcpf(1.0f + __expf(-((const float*)(ws + OFF_GACC))[(size_t)query * 48 + h * 3 + (MODE == 2 ? 0 : 1)]));
        if (MODE == 2) gold = __builtin_amdgcn_rcpf(1.0f + __expf(-((const float*)(ws + OFF_GACC))[(size_t)query * 48 + h * 3 + 2]));
        float* op = obuf + (size_t)query * DM + (MODE == 0 ? 0 : 2048) + h * 128 + qq * 4;
        f32x4 oldv[8];
        if (MODE >= 2) {
#pragma unroll
            for (int dt = 0; dt < 8; ++dt) oldv[dt] = *(const f32x4*)(op + dt * 16);
        }
#pragma unroll
        for (int dt = 0; dt < 8; ++dt) { f32x4 v = O[tq][dt] * sc; if (MODE >= 2) v = v + oldv[dt] * gold;
            if (MODE == 0 || MODE == 3) {
                u32x2 w; w.x = cvt_pk_bf16(v[0], v[1]); w.y = cvt_pk_bf16(v[2], v[3]);
                *(u32x2*)(onb + (size_t)query * DM + (MODE == 0 ? 0 : 2048) + h * 128 + qq * 4 + dt * 16) = w;
                ssq += (v[0] * v[0] + v[1] * v[1]) + (v[2] * v[2] + v[3] * v[3]);
            } else *(f32x4*)(op + dt * 16) = v; }
    }
    if ((MODE == 0 || MODE == 3) && !(MODE >= 2 && dry)) {
        ssq += __shfl_xor(ssq, 16); ssq += __shfl_xor(ssq, 32);
        if (MODE == 3) ssq += __shfl_xor(ssq, 1);
        if (qq == 0 && (MODE != 3 || (n & 1) == 0)) atomicAdd((float*)(ws + OFF_SSAB) + 2 * query + (MODE == 0 ? 0 : 1), ssq);
    }
    if (MODE == 2) {
        __syncthreads();
        const float* sc0 = (const float*)(shm + AL_SC); float* fs = (float*)(shm + AL_FS) + wid * 128;
        const int cur = qb, j0 = lane, j1 = lane + 64;
        for (int e = 0; e < 8; ++e) {
            const int ql = wid * 8 + e;
            float v0 = -1.f, v1 = -1.f;
            if (j0 <= cur) { v0 = sc0[j0 * 64 + ql] + sc0[(128 + j0) * 64 + ql]; if (j0 == 0 || j0 == cur || j0 == cur - 1) v0 = 1e6f; }
            if (j1 <= cur) { v1 = sc0[j1 * 64 + ql] + sc0[(128 + j1) * 64 + ql]; if (j1 == cur || j1 == cur - 1) v1 = 1e6f; }
            fs[j0] = v0; fs[j1] = v1;
            __builtin_amdgcn_wave_barrier();
            int r0 = 0, r1 = 0;
            for (int jj = 0; jj <= cur; ++jj) { const float o = fs[jj]; r0 += (o > v0 || (o == v0 && jj < j0)) ? 1 : 0; r1 += (o > v1 || (o == v1 && jj < j1)) ? 1 : 0; }
            const unsigned long long b0 = __ballot(j0 <= cur && r0 < 16), b1 = __ballot(j1 <= cur && r1 < 16);
            if (lane == 0) { u32x4 w; w.x = (unsigned)b0; w.y = (unsigned)(b0 >> 32); w.z = (unsigned)b1; w.w = (unsigned)(b1 >> 32);
                *(u32x4*)((unsigned*)(ws + OFF_SEL) + ((size_t)g * S_ + s0 + ql) * 4) = w; }
            __builtin_amdgcn_wave_barrier();
        }
    }
}
template <int MODE>
__device__ __forceinline__ void attn_phase(const Params& P, unsigned char* shm, int dry, int first = -1, int stride = 0) {
    if (first < 0) { first = blockIdx.x; stride = gridDim.x; }
    for (int it = first; it < 512; it += stride) {
        const int j = it & 255, g = (j & 7) >> 1, li = ((j & 1) << 5) | (j >> 3); const int qb = it < 256 ? li : 127 - li;
        attn_item<MODE>(P, shm, qb, g, dry);
    }
}

__device__ void phase_outnorm(const Params& P) {
    const int tid = threadIdx.x, wid = tid >> 6, lane = tid & 63;
    bf16_t* on = (bf16_t*)(P.ws + OFF_ON);
    for (int s = blockIdx.x * 8 + wid; s < S_; s += gridDim.x * 8) {
        const f32x4* r = (const f32x4*)(P.out + (size_t)s * DM);
#pragma unroll
        for (int grp = 0; grp < 2; ++grp) {
            f32x4 v[8]; float ss = 0.f;
#pragma unroll
            for (int i = 0; i < 8; ++i) { v[i] = r[grp * 512 + i * 64 + lane]; ss += (v[i][0] * v[i][0] + v[i][1] * v[i][1]) + (v[i][2] * v[i][2] + v[i][3] * v[i][3]); }
            ss = wave_sum(ss); const float rr = rsqrtf(ss * (1.0f / 2048.0f) + EPS_);
#pragma unroll
            for (int i = 0; i < 8; ++i) { u32x2 w; w.x = cvt_pk_bf16(v[i][0] * rr, v[i][1] * rr); w.y = cvt_pk_bf16(v[i][2] * rr, v[i][3] * rr);
                *(u32x2*)(on + (size_t)s * DM + (grp * 512 + i * 64 + lane) * 4) = w; }
        }
    }
}

__device__ __forceinline__ void cmp_slc_phase(const Params& P, unsigned char* shm, int dry) {
    int prev_g = -1;
    for (int it = blockIdx.x; it < 512; it += gridDim.x) {
        const int j = it & 255, g = (j & 7) >> 1, li = ((j & 1) << 5) | (j >> 3); const int qb = it < 256 ? li : 127 - li;
        attn_item<2>(P, shm, qb, g, dry, g != prev_g); prev_g = g;
        __builtin_amdgcn_fence(__ATOMIC_RELEASE, "workgroup"); __syncthreads(); __builtin_amdgcn_fence(__ATOMIC_ACQUIRE, "workgroup");
        attn_item<3>(P, shm, qb, g, dry, false);
    }
}

__device__ void phase_fixup(const Params& P, int pm_only, int first, int stride) {
    const float* stL = (const float*)(P.ws + OFF_STL); const float* stG = (const float*)(P.ws + OFF_STG); const float* stU = (const float*)(P.ws + OFF_STU);
    bf16_t* hf = (bf16_t*)(P.ws + OFF_HF);
    constexpr int NC4 = DFF / 4;
    const int nit = pm_only < 0 ? 64 * NC4 : 2 * NC4;
    for (int it = first; it < nit; it += stride) {
        const int c4 = it % NC4, pr = it / NC4 + (pm_only < 0 ? 0 : 2 * pm_only), rr = pr & 1, pm = pr >> 1, col = c4 * 4;
        f32x4 L0 = {0.f, 0.f, 0.f, 0.f}, L1 = {0.f, 0.f, 0.f, 0.f};
        if (pm > 0) { L0 = *(const f32x4*)(stL + ((size_t)(pm - 1) * 2 + 0) * DFF + col); L1 = *(const f32x4*)(stL + ((size_t)(pm - 1) * 2 + 1) * DFF + col); }
        const f32x4 F0 = *(const f32x4*)(stG + ((size_t)pm * 2 + 0) * DFF + col), F1 = *(const f32x4*)(stG + ((size_t)pm * 2 + 1) * DFF + col);
        const f32x4 uu = *(const f32x4*)(stU + ((size_t)pm * 2 + rr) * DFF + col);
        const f32x4 g2 = rr ? L1 : L0, g1 = rr ? F0 : L1, g0 = rr ? F1 : F0;
        const f32x4 w0 = *(const f32x4*)(P.conv_w + col), w1 = *(const f32x4*)(P.conv_w + DFF + col), w2 = *(const f32x4*)(P.conv_w + 2 * DFF + col), cb = *(const f32x4*)(P.conv_b + col);
        const f32x4 z = cb + w0 * g2 + w1 * g1 + w2 * g0;
        f32x4 hv;
#pragma unroll
        for (int j = 0; j < 4; ++j) hv[j] = z[j] * __builtin_amdgcn_rcpf(1.0f + __expf(-z[j])) * uu[j];
        u32x2 w; w.x = cvt_pk_bf16(hv[0], hv[1]); w.y = cvt_pk_bf16(hv[2], hv[3]);
        *(u32x2*)(hf + (size_t)(pm * 256 + rr) * DFF + col) = w;
    }
}

__device__ __forceinline__ void phase3(const Params& P, unsigned char* shm, int dry) {
    unsigned char* ws = P.ws; const int b = blockIdx.x, G = gridDim.x;
    if (b < 64) {
        const int kh = b >> 5; pg8::Gemm g{(const bf16_t*)(ws + OFF_IM2) + kh * 2048, (const bf16_t*)(ws + OFF_W1) + kh * 2048, 4096, 512, 2048, 4096}; pg8::StaticOrder so; so.init(4096, 512, 32, b & 31);
        pg8::Unit u0; const bool useful = so.next(0, u0) && (u0.pm >> 3) == u0.pn;
        if (useful) { EpiCmp e{(float*)(ws + OFF_HACC)}; pg8::gemm_phase<EpiCmp, pg8::StaticOrder, false>((PG8_LAS unsigned char*)shm, g, so, e, nullptr); } }
    else if (b < 128) {
        const int kh = (b - 64) >> 5; pg8::Gemm g{(const bf16_t*)(ws + OFF_XB) + kh * 2048, (const bf16_t*)(ws + OFF_WIN) + (size_t)8192 * DM + kh * 2048, S_, 256, 2048, 4096}; pg8::StaticOrder so; so.init(S_, 256, 32, (b - 64) & 31);
        EpiGates e{(float*)(ws + OFF_GACC), (const float*)(ws + OFF_RSTD0)}; pg8::gemm_phase<EpiGates, pg8::StaticOrder, false>((PG8_LAS unsigned char*)shm, g, so, e, nullptr); }
    unsigned* ctr = (unsigned*)(ws + OFF_QCTR);
    volatile LAS unsigned* qw = (volatile LAS unsigned*)(LAS unsigned char*)(shm + LDS_STAGE + 64);
    unsigned nxt = 0;
    if (threadIdx.x == 0) nxt = atomicAdd(ctr, 1u);
    for (;;) {
        __syncthreads();
        if (threadIdx.x == 0) qw[0] = nxt;
        __syncthreads();
        const int it = (int)qw[0];
        if (it >= 1024) break;
        if (threadIdx.x == 0) nxt = atomicAdd(ctr, 1u);
        const int i5 = it & 511, j = i5 & 255, g = j >> 6, qb = i5 < 256 ? (j & 63) : 127 - (j & 63);
        if (it < 512) attn_item<1>(P, shm, qb, g, dry); else attn_item<0>(P, shm, qb, g, dry);
    }
}


#define XB_TMO      128
#define XB_XCNT(j)  (256  + 64 * (j))
#define XB_XSUB(j)  (1280 + 64 * (j))
#define XB_XGEN(j)  (2304 + 64 * (j))
#define XB_TOP      3328
#define XB_TOPGEN   3392
#define XCD_BAR_WORDS 3456
#define XB_SPIN_CAP (1u << 18)

__device__ __forceinline__ unsigned xb_ld(unsigned* p)              { return __hip_atomic_load(p, __ATOMIC_RELAXED, __HIP_MEMORY_SCOPE_AGENT); }
__device__ __forceinline__ unsigned xb_add(unsigned* p, unsigned v) { return __hip_atomic_fetch_add(p, v, __ATOMIC_RELAXED, __HIP_MEMORY_SCOPE_AGENT); }
__device__ __forceinline__ unsigned xb_xcc_id() { return (unsigned)__builtin_amdgcn_s_getreg((3 << 11) | 20) & 0xFu; }
#define XB_SPIN(cond, bar) do { unsigned _sp = 0; while (cond) { __builtin_amdgcn_s_sleep(1); \
    if ((++_sp & 255u) == 0u) { if (xb_ld(&(bar)[XB_TMO])) break; if (_sp > XB_SPIN_CAP) { atomicAdd(&(bar)[XB_TMO], 1u); break; } } } } while (0)

struct XcdBarrier {
    unsigned* bar; unsigned x;
    volatile LAS unsigned* st;
};

__device__ __forceinline__ XcdBarrier xcd_barrier_post(unsigned* bar, volatile LAS unsigned* st) {
    XcdBarrier b; b.bar = bar; b.x = xb_xcc_id(); b.st = st;
    if (threadIdx.x == 0) (void)xb_add(&bar[XB_XCNT(b.x)], 1u);
    return b;
}
__device__ __forceinline__ void xcd_barrier_complete(unsigned* bar, unsigned x, unsigned& nloc, unsigned& nx) {
    const unsigned G = gridDim.x * gridDim.y * gridDim.z;
    unsigned sum, cnt, mine, sp = 0u;
    for (;;) {
        sum = 0u; cnt = 0u; mine = 0u;
#pragma unroll
        for (unsigned j = 0; j < 16; ++j) { const unsigned c = xb_ld(&bar[XB_XCNT(j)]); sum += c; cnt += (c > 0u) ? 1u : 0u; mine = (j == x) ? c : mine; }
        if (sum == G) break;
        __builtin_amdgcn_s_sleep(1);
        if ((++sp & 255u) == 0u) { if (xb_ld(&bar[XB_TMO])) break; if (sp > XB_SPIN_CAP) { atomicAdd(&bar[XB_TMO], 1u); break; } }
    }
    nloc = mine > 0u ? mine : 1u; nx = cnt > 0u ? cnt : 1u;
}

__device__ __forceinline__ void xcd_barrier(const XcdBarrier& b) {
    asm volatile("s_waitcnt vmcnt(0)" ::: "memory");
    __syncthreads();
    if (threadIdx.x == 0) {
        unsigned* bar = b.bar;
        __builtin_amdgcn_s_waitcnt(0);
        unsigned nloc = b.st[0], nx = b.st[1];
        if (nloc == 0u) { xcd_barrier_complete(bar, b.x, nloc, nx); b.st[0] = nloc; b.st[1] = nx; }
        const unsigned old = xb_add(&bar[XB_XSUB(b.x)], 1u);
        const unsigned gen = old / nloc;
        if (old + 1u == (gen + 1u) * nloc) {
            __builtin_amdgcn_fence(__ATOMIC_RELEASE, "agent");
            asm volatile("s_waitcnt vmcnt(0)" ::: "memory");
            const unsigned og = xb_add(&bar[XB_TOP], 1u);
            const unsigned tg = og / nx;
            if (og + 1u == (tg + 1u) * nx) xb_add(&bar[XB_TOPGEN], 1u);
            else XB_SPIN(xb_ld(&bar[XB_TOPGEN]) == tg, bar);
            __builtin_amdgcn_fence(__ATOMIC_ACQUIRE, "agent");
            xb_add(&bar[XB_XGEN(b.x)], 1u);
            asm volatile("s_waitcnt vmcnt(0)" ::: "memory");
        } else {
            XB_SPIN(xb_ld(&bar[XB_XGEN(b.x)]) == gen, bar);
            __builtin_amdgcn_fence(__ATOMIC_ACQUIRE, "agent");
            asm volatile("s_waitcnt vmcnt(0)" ::: "memory");
        }
    }
    __syncthreads();
}


constexpr int NPHASE = 12;
__global__ void __launch_bounds__(512, 2) hymba_mega(Params P) {
    extern __shared__ __attribute__((aligned(16))) unsigned char shm[];
    cg::grid_group grid = cg::this_grid();
    unsigned char* ws = P.ws;
    volatile LAS unsigned* xst = (volatile LAS unsigned*)(LAS unsigned char*)(shm + LDS_STAGE);
    if (threadIdx.x == 0) { xst[0] = 0u; xst[1] = 0u; }
    __syncthreads();
    const XcdBarrier xb = xcd_barrier_post((unsigned*)(ws + OFF_BAR), xst);
#define GSYNC(k) do { if ((k) == 0 && P.one == 0) grid.sync(); xcd_barrier(xb); } while (0)
#ifndef DUPMASK
#define DUPMASK 0
#endif
#define RUN_PHASE(k, ...) if (P.ph_lo <= (k) && (k) < P.ph_hi) { \
        if (DUPMASK & (1 << (k))) { const int dry = P.one; __VA_ARGS__ GSYNC(k); } \
        { const int dry = 0; (void)dry; __VA_ARGS__ } \
        if ((k) + 1 < P.ph_hi) GSYNC(k); }
#define GEMM_PHASE(EPI, Aoff, Boff, M_, N_, K_, ...) { pg8::Gemm g{(const bf16_t*)(ws + (Aoff)), (const bf16_t*)(ws + (Boff)), (M_), (N_), (K_), (K_)}; pg8::StaticOrder so; so.init((M_), (N_), (int)gridDim.x, (int)blockIdx.x); \
        EPI e{__VA_ARGS__}; pg8::gemm_phase<EPI, pg8::StaticOrder, false>((PG8_LAS unsigned char*)shm, g, so, e, nullptr); }
    RUN_PHASE(0, phase_prep(P, shm);)
    RUN_PHASE(1, GEMM_PHASE(EpiBf16Scale, OFF_XB, OFF_WIN, S_, 8192, DM, (bf16_t*)(ws + OFF_PROJ), NINP, (const float*)(ws + OFF_RSTD0), 0))
    RUN_PHASE(2, phase_norm(P, shm);)
    RUN_PHASE(3, phase3(P, shm, dry);)
    RUN_PHASE(4, phase_cmp2(P, shm);)
    RUN_PHASE(5, cmp_slc_phase(P, shm, dry);)
    RUN_PHASE(8, GEMM_PHASE(EpiOutProj, OFF_ON, OFF_WOUT, S_, DM, DM, P.x, P.out, (bf16_t*)(ws + OFF_X1B), (float*)(ws + OFF_SS1), dry, (const float*)(ws + OFF_SSAB)))
    RUN_PHASE(9, GEMM_PHASE(EpiGateUp, OFF_X1B, OFF_WGU, S_, NGU, DM, (bf16_t*)(ws + OFF_HF), (const float*)(ws + OFF_SS1), P.conv_w, P.conv_b, (float*)(ws + OFF_STL), (float*)(ws + OFF_STG), (float*)(ws + OFF_STU), (LAS float*)((PG8_LAS unsigned char*)shm + 131072)))
    RUN_PHASE(10, phase_fixup(P, -1, (int)(blockIdx.x * 512 + threadIdx.x), (int)(gridDim.x * 512));)
    RUN_PHASE(11, GEMM_PHASE(EpiDown, OFF_HF, OFF_WD, S_, DM, DFF, P.out, dry))
}

extern "C" void kernel_launch(void* const* d_in, const int* in_sizes, int n_in, void* d_out, int out_size, void* d_ws, size_t ws_size, hipStream_t stream) {
    static int grid_blocks = 0;
    if (grid_blocks == 0) {
        if (n_in != 22 || out_size != S_ * DM || ws_size < WS_END) { fprintf(stderr, "kernel_launch: unexpected shapes (n_in %d out %d ws %zu need %zu)\n", n_in, out_size, ws_size, (size_t)WS_END); grid_blocks = -1; return; }
        int dev = 0, cus = 0, per_cu = 0;
        hipGetDevice(&dev); hipDeviceGetAttribute(&cus, hipDeviceAttributeMultiprocessorCount, dev);
        if (hipFuncSetAttribute((const void*)hymba_mega, hipFuncAttributeMaxDynamicSharedMemorySize, LDS_BYTES) != hipSuccess) { fprintf(stderr, "kernel_launch: hipFuncSetAttribute failed\n"); grid_blocks = -1; return; }
        if (hipOccupancyMaxActiveBlocksPerMultiprocessor(&per_cu, (const void*)hymba_mega, 512, LDS_BYTES) != hipSuccess || per_cu < 1) { fprintf(stderr, "kernel_launch: occupancy query failed (%d)\n", per_cu); (void)hipGetLastError(); per_cu = 1; }
        grid_blocks = cus * per_cu;
        if (grid_blocks < 128) { fprintf(stderr, "kernel_launch: this kernel needs >= 128 co-resident workgroups (got %d)\n", grid_blocks); grid_blocks = -1; return; }
    }
    if (grid_blocks < 0) return;
    Params P{};
    const float** pp = (const float**)&P;
    for (int i = 0; i < 22; ++i) pp[i] = (const float*)d_in[i];
    P.out = (float*)d_out; P.ws = (unsigned char*)d_ws; P.ph_lo = 0; P.ph_hi = NPHASE; P.one = 1;
    if (hipMemsetAsync((unsigned char*)d_ws + OFF_BAR, 0, XCD_BAR_WORDS * sizeof(unsigned), stream) != hipSuccess) { fprintf(stderr, "kernel_launch: memset failed\n"); return; }
    void* args[] = {&P};
    hipError_t e = hipLaunchCooperativeKernel((const void*)hymba_mega, dim3(grid_blocks), dim3(512), args, LDS_BYTES, stream);
    if (e != hipSuccess) fprintf(stderr, "cooperative launch failed: %s (grid %d)\n", hipGetErrorString(e), grid_blocks);
}
```
